# Optimizing an MI355X kernel written in HIP

```python
import jax, jax.numpy as jnp
from jax import lax
import numpy as np

D_MODEL = 1024
BATCH = 16
SEQ = 2048
DEPTH = 4

CTX_LEN = 256
GRID_W = 64

RWKV_HEAD_DIM = 64
RWKV_DIM = D_MODEL
RWKV_HEADS = RWKV_DIM // RWKV_HEAD_DIM
DECAY_LORA = 64
ICLR_LORA = 64
GATE_LORA = 128
CONV_DIM = D_MODEL // 2
CONV_WIDTH = 31
SGU_DIM = D_MODEL // 2
SGU_GROUPS = 8
CHUNK = 128
D_FF = ((8 * D_MODEL // 3 + 255) // 256) * 256
N_BRANCH = 3
NORM_EPS = 1e-6
LN_EPS = 1e-5
GN_EPS = 64e-5

OFF_R = 0
OFF_K = OFF_R + RWKV_DIM
OFF_V = OFF_K + RWKV_DIM
OFF_WF = OFF_V + RWKV_DIM
OFF_WB = OFF_WF + DECAY_LORA
OFF_AF = OFF_WB + DECAY_LORA
OFF_AB = OFF_AF + ICLR_LORA
OFF_G = OFF_AB + ICLR_LORA
RWKV_COLS = OFF_G + GATE_LORA
OFF_CONV = RWKV_COLS
OFF_SGU = OFF_CONV + 2 * CONV_DIM
OFF_GATE = OFF_SGU + 2 * SGU_DIM
P_IN = OFF_GATE + N_BRANCH * D_MODEL

kernel_name = "hybrid_rwkv7_conformer_sgu_prefix_dit"


def _standardize(x, eps):
    xf = x.astype(jnp.float32)
    xc = xf - jnp.mean(xf, -1, keepdims=True)
    return xc * lax.rsqrt(jnp.mean(xc * xc, -1, keepdims=True) + eps)


def rms_norm(x, g):
    xf = x.astype(jnp.float32)
    y = xf * lax.rsqrt(jnp.mean(xf * xf, -1, keepdims=True) + NORM_EPS)
    return (y * g.astype(jnp.float32)).astype(x.dtype)


def layer_norm(x, g, b):
    return (_standardize(x, LN_EPS) * g + b).astype(x.dtype)


def modulate(h, shift, scale):
    return h * (1 + scale) + shift


def short_conv(z, w):
    zp = jnp.pad(z, ((0, 0), (1, 1), (0, 0)))
    return zp[:, :-2] * w[0] + zp[:, 1:-1] * w[1] + zp[:, 2:] * w[2]


def to_heads(t):
    B, T = t.shape[:2]
    return t.astype(jnp.float32).reshape(B, T, RWKV_HEADS, RWKV_HEAD_DIM)


def rwkv_inputs(z, w0, w_up, a0, a_up, k_k, k_a):
    k = z[..., OFF_K:OFF_V]
    v = to_heads(z[..., OFF_V:OFF_WF])
    kk = to_heads(k * k_k)
    kk = kk * lax.rsqrt(jnp.maximum(jnp.sum(kk * kk, -1, keepdims=True), 1e-24))
    kf = k.astype(jnp.float32)
    dirs = []
    for d, (ow, oa) in enumerate(((OFF_WF, OFF_AF), (OFF_WB, OFF_AB))):
        lw = (w0[d] + jnp.tanh(z[..., ow:ow + DECAY_LORA]) @ w_up[d]).astype(jnp.float32)
        decay = jnp.exp(-jnp.exp(-jax.nn.softplus(-lw) - 0.5))
        a = jax.nn.sigmoid((a0[d] + z[..., oa:oa + ICLR_LORA] @ a_up[d]).astype(jnp.float32))
        k_d = kf * (1.0 + (a - 1.0) * k_a.astype(jnp.float32))
        dirs.append((to_heads(decay), to_heads(k_d), kk * to_heads(a)))
    return to_heads(k), v, kk, dirs


def wkv_scan(S0, decay, k, v, kk, kka, r, reverse):
    want_y = r is not None

    def step(S, inp):
        w_t, k_t, v_t, kk_t, kka_t = inp[:5]
        sa = jnp.einsum('bhvk,bhk->bhv', S, kk_t)
        S = (S * w_t[:, :, None, :] - sa[..., None] * kka_t[:, :, None, :]
             + v_t[..., None] * k_t[:, :, None, :])
        y = jnp.einsum('bhvk,bhk->bhv', S, inp[5]) if want_y else None
        return S, y

    seq = (decay, k, v, kk, kka) + ((r,) if want_y else ())
    xs = tuple(jnp.swapaxes(t, 0, 1) for t in seq)
    S, ys = lax.scan(step, S0, xs, reverse=reverse)
    return S, (jnp.swapaxes(ys, 0, 1) if want_y else None)


def rwkv_output(y, r, k, v, gz, gn_g, gn_b, r_k, g_up, w_out, dtype):
    B, T = y.shape[:2]
    yn = _standardize(y, GN_EPS).reshape(B, T, RWKV_DIM) * gn_g + gn_b
    bonus = jnp.sum(r * k * r_k.reshape(RWKV_HEADS, RWKV_HEAD_DIM), -1, keepdims=True) * v
    g = jax.nn.sigmoid(gz) @ g_up
    return ((yn + bonus.reshape(B, T, RWKV_DIM)).astype(dtype) * g) @ w_out


def conformer_branch(z, dw, dw_b, ln_g, ln_b, w_out, grid, horizontal):
    u = z[..., :CONV_DIM] * jax.nn.sigmoid(z[..., CONV_DIM:])
    B, T, C = u.shape
    if grid:
        u4 = u.reshape(B, T // GRID_W, GRID_W, C)
        w = dw[None, :, None, :] if horizontal else dw[:, None, None, :]
    else:
        u4 = u.reshape(B, 1, T, C)
        w = dw[None, :, None, :]
    y = lax.conv_general_dilated(u4, w.astype(u4.dtype), (1, 1), 'SAME',
                                 dimension_numbers=('NHWC', 'HWIO', 'NHWC'),
                                 feature_group_count=C)
    y = layer_norm(y.reshape(B, T, C) + dw_b, ln_g, ln_b)
    return jax.nn.silu(y) @ w_out


def sgu_branch(z, ln_g, ln_b, w_s, b_s, w_out):
    z = jax.nn.gelu(z)
    u, v = z[..., :SGU_DIM], z[..., SGU_DIM:]
    v = layer_norm(v, ln_g, ln_b)
    B, T, _ = v.shape
    v = v.reshape(B, T // CHUNK, CHUNK, SGU_GROUPS, SGU_DIM // SGU_GROUPS)
    v = jnp.einsum('gpq,bnqgd->bnpgd', w_s, v) + b_s.T[:, :, None]
    return (u * v.reshape(B, T, SGU_DIM)) @ w_out


def merge(z, branches, w_o):
    B, T, _ = z.shape
    g = jax.nn.sigmoid(z[..., OFF_GATE:].reshape(B, T, N_BRANCH, D_MODEL))
    m = branches[0] * g[:, :, 0] + branches[1] * g[:, :, 1] + branches[2] * g[:, :, 2]
    return m @ w_o


def swiglu(h, w_in, w_out):
    gu = h @ w_in
    return (jax.nn.silu(gu[..., :D_FF]) * gu[..., D_FF:]) @ w_out


def setup_inputs(seed: int = 0) -> dict:
    key = jax.random.key(seed)
    k = jax.random.split(key, 36)
    L, D, RD = DEPTH, D_MODEL, RWKV_DIM

    def nrm(i, shape, scale):
        return jax.random.normal(k[i], shape, jnp.float32) * scale

    shift_base = jnp.array([0.25, 1.0, 0.25], jnp.float32)[None, :, None]
    return {
        'x': nrm(0, (BATCH, SEQ, D), 1.0),
        'c': nrm(1, (BATCH, D), 1.0),
        'ctx': nrm(2, (BATCH, CTX_LEN, D), 1.0),
        'c_ctx': nrm(3, (D,), 1.0),
        'w_mod': nrm(4, (L, D, 6 * D), 0.5 * D ** -0.5),
        'b_mod': nrm(5, (L, 6 * D), 0.01),
        'norm1_g': 1.0 + nrm(6, (L, D), 0.05),
        'norm2_g': 1.0 + nrm(7, (L, D), 0.05),
        'w_in': nrm(8, (L, D, P_IN), D ** -0.5),
        'rwkv_shift': shift_base + nrm(9, (L, 3, RWKV_COLS), 0.1),
        'rwkv_w0': jax.random.uniform(k[10], (L, 2, RD), jnp.float32, -4.0, 1.0),
        'rwkv_w_up': nrm(11, (L, 2, DECAY_LORA, RD), 0.5 * DECAY_LORA ** -0.5),
        'rwkv_a0': nrm(12, (L, 2, RD), 0.5),
        'rwkv_a_up': nrm(13, (L, 2, ICLR_LORA, RD), 0.5 * ICLR_LORA ** -0.5),
        'rwkv_g_up': nrm(14, (L, GATE_LORA, RD), GATE_LORA ** -0.5),
        'rwkv_k_k': 0.85 + nrm(15, (L, RD), 0.05),
        'rwkv_k_a': 1.0 + nrm(16, (L, RD), 0.05),
        'rwkv_r_k': nrm(17, (L, RD), 0.1),
        'rwkv_gn_g': 1.0 + nrm(18, (L, RD), 0.05),
        'rwkv_gn_b': nrm(19, (L, RD), 0.01),
        'rwkv_out': nrm(20, (L, RD, D), RD ** -0.5),
        'conv_dw': nrm(21, (L, CONV_WIDTH, CONV_DIM), CONV_WIDTH ** -0.5),
        'conv_dw_b': nrm(22, (L, CONV_DIM), 0.01),
        'conv_ln_g': 1.0 + nrm(23, (L, CONV_DIM), 0.05),
        'conv_ln_b': nrm(24, (L, CONV_DIM), 0.01),
        'conv_out': nrm(25, (L, CONV_DIM, D), CONV_DIM ** -0.5),
        'sgu_ln_g': 1.0 + nrm(26, (L, SGU_DIM), 0.05),
        'sgu_ln_b': nrm(27, (L, SGU_DIM), 0.01),
        'sgu_w': nrm(28, (L, SGU_GROUPS, CHUNK, CHUNK), 0.5 * CHUNK ** -0.5),
        'sgu_b': 1.0 + nrm(29, (L, SGU_GROUPS, CHUNK), 0.1),
        'sgu_out': nrm(30, (L, SGU_DIM, D), SGU_DIM ** -0.5),
        'w_merge': nrm(31, (L, D, D), D ** -0.5),
        'ffn_w_in': nrm(32, (L, D, 2 * D_FF), D ** -0.5),
        'ffn_w_out': nrm(33, (L, D_FF, D), D_FF ** -0.5),
        'final_norm_g': 1.0 + nrm(34, (D,), 0.05),
    }


def reference(x, c, ctx, c_ctx, w_mod, b_mod, norm1_g, norm2_g, w_in, rwkv_shift,
              rwkv_w0, rwkv_w_up, rwkv_a0, rwkv_a_up, rwkv_g_up, rwkv_k_k, rwkv_k_a,
              rwkv_r_k, rwkv_gn_g, rwkv_gn_b, rwkv_out, conv_dw, conv_dw_b, conv_ln_g,
              conv_ln_b, conv_out, sgu_ln_g, sgu_ln_b, sgu_w, sgu_b, sgu_out, w_merge,
              ffn_w_in, ffn_w_out, final_norm_g):
    s0 = jnp.zeros((x.shape[0], RWKV_HEADS, RWKV_HEAD_DIM, RWKV_HEAD_DIM), jnp.float32)
    sc_lat = jax.nn.silu(c)
    sc_ctx = jax.nn.silu(c_ctx)
    h_ctx = ctx
    for l in range(DEPTH):
        need_ctx = l < DEPTH - 1
        sh1, sc1, g1, sh2, sc2, g2 = jnp.split((sc_lat @ w_mod[l] + b_mod[l])[:, None, :], 6, axis=-1)
        n_c = 6 if need_ctx else 2
        mc = jnp.split(sc_ctx @ w_mod[l][:, :n_c * D_MODEL] + b_mod[l][:n_c * D_MODEL], n_c)

        hx = modulate(rms_norm(x, norm1_g[l]), sh1, sc1)
        hc = modulate(rms_norm(h_ctx, norm1_g[l]), mc[0], mc[1])
        zx = hx @ w_in[l]
        zc = hc @ (w_in[l] if need_ctx else w_in[l][:, :RWKV_COLS])

        zr_x = short_conv(zx[..., :RWKV_COLS], rwkv_shift[l])
        zr_c = short_conv(zc[..., :RWKV_COLS], rwkv_shift[l])
        lora = (rwkv_w0[l], rwkv_w_up[l], rwkv_a0[l], rwkv_a_up[l], rwkv_k_k[l], rwkv_k_a[l])
        k_x, v_x, kk_x, dirs_x = rwkv_inputs(zr_x, *lora)
        k_c, v_c, kk_c, dirs_c = rwkv_inputs(zr_c, *lora)
        r_x = to_heads(zr_x[..., OFF_R:OFF_K])
        r_c = to_heads(zr_c[..., OFF_R:OFF_K]) if need_ctx else None
        y_lat, y_ctx = [], []
        for d, rev in enumerate((False, True)):
            dec_c, kd_c, kka_c = dirs_c[d]
            s_ctx, yc = wkv_scan(s0, dec_c, kd_c, v_c, kk_c, kka_c, r_c, rev)
            dec_x, kd_x, kka_x = dirs_x[d]
            _, yx = wkv_scan(s_ctx, dec_x, kd_x, v_x, kk_x, kka_x, r_x, rev)
            y_lat.append(yx)
            y_ctx.append(yc)
        out_par = (rwkv_gn_g[l], rwkv_gn_b[l], rwkv_r_k[l], rwkv_g_up[l], rwkv_out[l])
        a_x = rwkv_output(y_lat[0] + y_lat[1], r_x, k_x, v_x, zr_x[..., OFF_G:RWKV_COLS],
                          *out_par, x.dtype)
        conv_par = (conv_dw[l], conv_dw_b[l], conv_ln_g[l], conv_ln_b[l], conv_out[l])
        b_x = conformer_branch(zx[..., OFF_CONV:OFF_SGU], *conv_par, True, l % 2 == 0)
        sgu_par = (sgu_ln_g[l], sgu_ln_b[l], sgu_w[l], sgu_b[l], sgu_out[l])
        c_x = sgu_branch(zx[..., OFF_SGU:OFF_GATE], *sgu_par)
        x_new = x + g1 * merge(zx, (a_x, b_x, c_x), w_merge[l])
        if need_ctx:
            a_c = rwkv_output(y_ctx[0] + y_ctx[1], r_c, k_c, v_c, zr_c[..., OFF_G:RWKV_COLS],
                              *out_par, h_ctx.dtype)
            b_c = conformer_branch(zc[..., OFF_CONV:OFF_SGU], *conv_par, False, True)
            c_c = sgu_branch(zc[..., OFF_SGU:OFF_GATE], *sgu_par)
            h_ctx = h_ctx + mc[2] * merge(zc, (a_c, b_c, c_c), w_merge[l])
        x = x_new

        x = x + g2 * swiglu(modulate(rms_norm(x, norm2_g[l]), sh2, sc2), ffn_w_in[l], ffn_w_out[l])
        if need_ctx:
            h_ctx = h_ctx + mc[5] * swiglu(modulate(rms_norm(h_ctx, norm2_g[l]), mc[3], mc[4]),
                                           ffn_w_in[l], ffn_w_out[l])
    return rms_norm(x, final_norm_g)
```

```cpp
#include <hip/hip_runtime.h>
#include <hip/hip_cooperative_groups.h>
namespace cg = cooperative_groups;

#ifndef COOP
#define COOP 0
#endif

typedef _Float16 h16;
typedef _Float16 h16x8 __attribute__((ext_vector_type(8)));
typedef _Float16 h16x4 __attribute__((ext_vector_type(4)));
typedef float f32x4 __attribute__((ext_vector_type(4)));

constexpr int D = 1024, NB = 16, SEQ = 2048, DEPTH = 4, CTX = 256;
constexpr int PIN = 8576, PINP = 8704, RC = 3456, OFF_CONV = 3456, OFF_SGU = 4480, OFF_GATE = 5504;
constexpr int DFF = 2816;
constexpr int GB = 4, NG = NB / GB;
constexpr int MLAT = GB * SEQ, MCTX = GB * CTX, MG = MLAT + MCTX;
constexpr int NTHREADS = 512;
constexpr int SHM_BYTES = 131072;

constexpr size_t al256(size_t x) { return (x + 255) / 256 * 256; }
constexpr size_t OFF_MOD = 0;
constexpr size_t OFF_CTXX = al256(OFF_MOD + (size_t)4 * 17 * 6144 * 4);
constexpr size_t OFF_WINT = al256(OFF_CTXX + (size_t)NB * CTX * D * 4);
constexpr size_t OFF_FFNINT = al256(OFF_WINT + (size_t)PINP * D * 2);
constexpr size_t OFF_FFNOUTT = al256(OFF_FFNINT + (size_t)2 * DFF * D * 2);
constexpr size_t OFF_ROUTT = al256(OFF_FFNOUTT + (size_t)D * DFF * 2);
constexpr size_t OFF_WMT = al256(OFF_ROUTT + (size_t)D * D * 2);
constexpr size_t OFF_COUTT = al256(OFF_WMT + (size_t)D * D * 2);
constexpr size_t OFF_SOUTT = al256(OFF_COUTT + (size_t)D * 512 * 2);
constexpr size_t OFF_SGUW = al256(OFF_SOUTT + (size_t)D * 512 * 2);
constexpr size_t OFF_H = al256(OFF_SGUW + (size_t)8 * 128 * 128 * 2);
constexpr size_t OFF_Z = al256(OFF_H + (size_t)MG * D * 2);
constexpr size_t OFF_Y = al256(OFF_Z + (size_t)MG * PINP * 2);
constexpr size_t OFF_APRE = al256(OFF_Y + (size_t)2 * MG * D * 4);
constexpr size_t OFF_BPRE = al256(OFF_APRE + (size_t)MG * D * 2);
constexpr size_t OFF_CPRE = al256(OFF_BPRE + (size_t)MG * 512 * 2);
constexpr size_t OFF_M16 = al256(OFF_CPRE + (size_t)MG * 512 * 2);
constexpr size_t WS_TOTAL = al256(OFF_M16 + (size_t)MG * D * 2);

struct P {
  const float* in[35];
  float* out;
  char* ws;
};
typedef const __attribute__((address_space(4))) P CP4;

__device__ __forceinline__ float wave_sum(float v) {
#pragma unroll
  for (int m = 32; m >= 1; m >>= 1) v += __shfl_xor(v, m, 64);
  return v;
}
__device__ __forceinline__ float sigmoidf_(float x) { return 1.0f / (1.0f + __expf(-x)); }
__device__ __forceinline__ float siluf_(float x) { return x * sigmoidf_(x); }
__device__ __forceinline__ float geluf_(float x) {
  float u = 0.7978845608028654f * (x + 0.044715f * x * x * x);
  return 0.5f * x * (1.0f + tanhf(u));
}
__device__ __forceinline__ float* xrow2(float* out, char* ws, int g, int r) {
  return (r < MLAT) ? out + ((size_t)g * MLAT + r) * D
                    : (float*)(ws + OFF_CTXX) + ((size_t)g * MCTX + (r - MLAT)) * D;
}
__device__ __forceinline__ const float* modrow2(const char* ws, int l, int g, int r) {
  int i = (r < MLAT) ? (g * GB + r / SEQ) : 16;
  return (const float*)(ws + OFF_MOD) + ((size_t)l * 17 + i) * 6144;
}
__device__ __forceinline__ float* xrow(CP4& p, int g, int r) { return xrow2(p.out, p.ws, g, r); }
__device__ __forceinline__ const float* modrow(CP4& p, int l, int g, int r) { return modrow2(p.ws, l, g, r); }
__device__ __forceinline__ void seqpos(int r, int& t, int& L) {
  if (r < MLAT) { t = r % SEQ; L = SEQ; } else { t = (r - MLAT) % CTX; L = CTX; }
}
__device__ __forceinline__ float zshift(const h16* Z, const float* sw, int r, int t, int L, int col) {
  float v = (float)Z[(size_t)r * PINP + col] * sw[RC + col];
  if (t > 0) v += (float)Z[(size_t)(r - 1) * PINP + col] * sw[col];
  if (t < L - 1) v += (float)Z[(size_t)(r + 1) * PINP + col] * sw[2 * RC + col];
  return v;
}

#define LAS __attribute__((address_space(3)))
constexpr int BM = 256, BK = 64, HALF = 128, HTB = HALF * BK * 2;
__device__ __forceinline__ int lds_byte(int r, int c) {
  int st = (r >> 4) * 2 + (c >> 5), rr = r & 15, cc = c & 31, ob = rr * 64 + cc * 2;
  return st * 1024 + (ob ^ (((ob >> 9) & 1) << 5));
}
__device__ __forceinline__ void stage_rc(int b, int& R, int& C) {
  int st = b / 1024, sb = b % 1024, swz = sb ^ (((sb >> 9) & 1) << 5);
  R = (st >> 1) * 16 + swz / 64; C = (st & 1) * 32 + (swz % 64) / 2;
}
__device__ __forceinline__ bool tile_of(int i, int nM, int nN, int& pm, int& pn) {
  const int NXCD = 8, WGM = 8;
  int nwg = nM * nN;
  long Lq = (long)i * gridDim.x + blockIdx.x; if (Lq >= nwg) return false;
  int wgid = (int)Lq;
  { int q = nwg / NXCD, r = nwg % NXCD, xcd = wgid % NXCD, off = wgid / NXCD;
    wgid = (xcd < r ? xcd * (q + 1) : r * (q + 1) + (xcd - r) * q) + off; }
  int nig = WGM * nN, gid = wgid / nig, fm = gid * WGM, gsz = min(nM - fm, WGM);
  pm = fm + ((wgid % nig) % gsz); pn = (wgid % nig) / gsz;
  return true;
}

template <class Epi>
__device__ __forceinline__ void gemm_phase(LAS unsigned char* lds, const h16* Ag, const h16* Btg, int K, int row0, int nM, int nN, const Epi& E) {
  const int tid = threadIdx.x, wid = __builtin_amdgcn_readfirstlane(tid >> 6), lane = tid & 63, wr = wid >> 2, wc = wid & 3, fr = lane & 15, fq = lane >> 4;
  const int nt = K / BK;
  unsigned voffA[2];
#pragma unroll
  for (int i = 0; i < 2; ++i) { int R, C; stage_rc(tid * 16 + i * 8192, R, C); voffA[i] = (unsigned)(R * K + C) * 2u; }
  const size_t kstep = (size_t)(BK * 2);
  const size_t hstep = (size_t)HALF * K * 2;
  const size_t tstep = 2 * hstep;
  const unsigned ldsw = (unsigned)wid * 1024u;
  const int aoff = lds_byte(wr * 64 + fr, fq * 8), boff = lds_byte(wc * 32 + fr, fq * 8);
  const char* Abase = (const char*)(Ag + (size_t)row0 * K);
#define PG8_SA(b, h) (((b) * 2 + (h)) * HTB)
#define PG8_SB(b, h) ((4 + (b) * 2 + (h)) * HTB)
#define PG8_STAGE(bufoff, gbase, voff) do { _Pragma("unroll") for (int _i = 0; _i < 2; ++_i) \
    __builtin_amdgcn_global_load_lds((const unsigned*)((const char*)(gbase) + (voff)[_i]), (LAS unsigned*)(lds + (bufoff) + ldsw + _i * 8192), 16, 0, 0); } while (0)
#define PG8_LDA(dst, b, h) do { _Pragma("unroll") for (int m = 0; m < 4; ++m) _Pragma("unroll") for (int k = 0; k < 2; ++k) dst[m][k] = *(const LAS h16x8*)(lds + PG8_SA(b, h) + aoff + m * 2048 + k * 1024); } while (0)
#define PG8_LDB(dst, b, h) do { _Pragma("unroll") for (int n = 0; n < 2; ++n) _Pragma("unroll") for (int k = 0; k < 2; ++k) dst[n][k] = *(const LAS h16x8*)(lds + PG8_SB(b, h) + boff + n * 2048 + k * 1024); } while (0)
#define PG8_MMA(ai, bj, At, Bt) do { __builtin_amdgcn_s_setprio(1); _Pragma("unroll") for (int m = 0; m < 4; ++m) _Pragma("unroll") for (int n = 0; n < 2; ++n) _Pragma("unroll") for (int k = 0; k < 2; ++k) \
    acc[ai][bj][m][n] = __builtin_amdgcn_mfma_f32_16x16x32_f16(Bt[n][k], At[m][k], acc[ai][bj][m][n], 0, 0, 0); __builtin_amdgcn_s_setprio(0); } while (0)
#define PG8_WAIT_V(n) asm volatile("s_waitcnt vmcnt(" #n ")" ::: "memory")
#define PG8_WAIT_L(n) asm volatile("s_waitcnt lgkmcnt(" #n ")" ::: "memory")
#define PG8_BAR __builtin_amdgcn_s_barrier()
#define PG8_SCHED __builtin_amdgcn_sched_barrier(0)
  int cpm, cpn, npm, npn, ui = 0;
  __syncthreads();
  if (!tile_of(0, nM, nN, cpm, cpn)) return;
  f32x4 acc[2][2][4][2];
#pragma unroll
  for (int a = 0; a < 2; ++a)
#pragma unroll
    for (int b = 0; b < 2; ++b)
#pragma unroll
      for (int m = 0; m < 4; ++m)
#pragma unroll
        for (int n = 0; n < 2; ++n) acc[a][b][m][n] = (f32x4){0.f, 0.f, 0.f, 0.f};
  h16x8 At[4][2], B0[2][2], B1[2][2];
  const char* cA = Abase + (size_t)cpm * tstep; const char* cB = (const char*)Btg + (size_t)cpn * tstep;
  PG8_STAGE(PG8_SB(0, 0), cB, voffA); PG8_STAGE(PG8_SA(0, 0), cA, voffA); PG8_STAGE(PG8_SB(0, 1), cB + hstep, voffA); PG8_STAGE(PG8_SA(0, 1), cA + hstep, voffA);
  if (wr == 1) PG8_BAR;
  PG8_WAIT_V(4); PG8_BAR;
  PG8_STAGE(PG8_SB(1, 0), cB + kstep, voffA); PG8_STAGE(PG8_SA(1, 0), cA + kstep, voffA); PG8_STAGE(PG8_SB(1, 1), cB + hstep + kstep, voffA);
  PG8_WAIT_V(6); PG8_BAR;
  for (;;) {
    const bool has_next = tile_of(ui + 1, nM, nN, npm, npn);
    const char* nA = has_next ? Abase + (size_t)npm * tstep : cA; const char* nB = has_next ? (const char*)Btg + (size_t)npn * tstep : cB;
    for (int t = 0; t < nt; t += 2) {
      const bool last = (t == nt - 2);
      const char* a1 = cA + (size_t)(t + 1) * kstep;
      const char* a2 = last ? nA : cA + (size_t)(t + 2) * kstep; const char* b2 = last ? nB : cB + (size_t)(t + 2) * kstep;
      const char* a3 = a2 + kstep; const char* b3 = b2 + kstep;
      PG8_LDB(B0, 0, 0); PG8_SCHED; PG8_LDA(At, 0, 0); PG8_STAGE(PG8_SA(1, 1), a1 + hstep, voffA);
      PG8_WAIT_L(8); PG8_BAR; PG8_WAIT_L(0); PG8_MMA(0, 0, At, B0); PG8_BAR; PG8_SCHED;
      PG8_LDB(B1, 0, 1); PG8_STAGE(PG8_SB(0, 0), b2, voffA);
      PG8_BAR; PG8_WAIT_L(0); PG8_MMA(0, 1, At, B1); PG8_BAR;
      PG8_LDA(At, 0, 1); PG8_STAGE(PG8_SA(0, 0), a2, voffA);
      PG8_BAR; PG8_WAIT_L(0); PG8_MMA(1, 0, At, B0); PG8_BAR; PG8_SCHED;
      PG8_STAGE(PG8_SB(0, 1), b2 + hstep, voffA);
      PG8_WAIT_V(6); PG8_BAR; PG8_MMA(1, 1, At, B1); PG8_BAR;
      PG8_LDB(B0, 1, 0); PG8_SCHED; PG8_LDA(At, 1, 0); PG8_STAGE(PG8_SA(0, 1), a2 + hstep, voffA);
      PG8_WAIT_L(8); PG8_BAR; PG8_WAIT_L(0); PG8_MMA(0, 0, At, B0); PG8_BAR; PG8_SCHED;
      PG8_LDB(B1, 1, 1); PG8_STAGE(PG8_SB(1, 0), b3, voffA);
      PG8_BAR; PG8_WAIT_L(0); PG8_MMA(0, 1, At, B1); PG8_BAR;
      PG8_LDA(At, 1, 1); PG8_STAGE(PG8_SA(1, 0), a3, voffA);
      PG8_BAR; PG8_WAIT_L(0); PG8_MMA(1, 0, At, B0); PG8_BAR; PG8_SCHED;
      PG8_STAGE(PG8_SB(1, 1), b3 + hstep, voffA);
      PG8_WAIT_V(6); PG8_BAR; PG8_MMA(1, 1, At, B1); PG8_BAR;
    }
    E(acc, row0 + cpm * BM, cpn * BM, wr, wc, fr, fq);
    if (!has_next) break;
#pragma unroll
    for (int a = 0; a < 2; ++a)
#pragma unroll
      for (int b = 0; b < 2; ++b)
#pragma unroll
        for (int m = 0; m < 4; ++m)
#pragma unroll
          for (int n = 0; n < 2; ++n) acc[a][b][m][n] = (f32x4){0.f, 0.f, 0.f, 0.f};
    cpm = npm; cpn = npn; cA = nA; cB = nB; ++ui;
  }
  PG8_WAIT_V(0);
  if (wr == 0) PG8_BAR;
  PG8_BAR;
#undef PG8_SA
#undef PG8_SB
#undef PG8_STAGE
#undef PG8_LDA
#undef PG8_LDB
#undef PG8_MMA
}

template <int MODE>
struct EpiAny {
  static constexpr int mode = (MODE == 6) ? 4 : MODE; h16* O16; const h16* Z; float* MT; float* out; char* ws; int l, g, goff;
  __device__ __forceinline__ void operator()(const f32x4 (&acc)[2][2][4][2], int brow, int bcol, int wr, int wc, int fr, int fq) const {
    if (mode == 0) {
#pragma unroll
      for (int ai = 0; ai < 2; ++ai)
#pragma unroll
        for (int m = 0; m < 4; ++m) {
          int row = brow + ai * 128 + wr * 64 + m * 16 + fr;
#pragma unroll
          for (int bj = 0; bj < 2; ++bj)
#pragma unroll
            for (int n = 0; n < 2; ++n) {
              int col = bcol + bj * 128 + wc * 32 + n * 16 + fq * 4;
              f32x4 a = acc[ai][bj][m][n];
              h16x4 o = {(h16)a[0], (h16)a[1], (h16)a[2], (h16)a[3]};
              *(h16x4*)(O16 + (size_t)row * PINP + col) = o;
            }
        }
    } else if (mode <= 3) {
      const int bm = mode - 1;
#pragma unroll
      for (int ai = 0; ai < 2; ++ai)
#pragma unroll
        for (int m = 0; m < 4; ++m) {
          int row = brow + ai * 128 + wr * 64 + m * 16 + fr;
#pragma unroll
          for (int bj = 0; bj < 2; ++bj)
#pragma unroll
            for (int n = 0; n < 2; ++n) {
              int col = bcol + bj * 128 + wc * 32 + n * 16 + fq * 4;
              h16x4 gt = *(const h16x4*)(Z + (size_t)row * PINP + OFF_GATE + bm * D + col);
              f32x4 a = acc[ai][bj][m][n];
              f32x4 v;
#pragma unroll
              for (int j = 0; j < 4; ++j) v[j] = a[j] * sigmoidf_((float)gt[j]);
              float* mp = MT + (size_t)row * D + col;
              if (bm == 0) { *(f32x4*)mp = v; }
              else if (bm == 1) { f32x4 o = *(f32x4*)mp; *(f32x4*)mp = o + v; }
              else { f32x4 o = *(f32x4*)mp; v = v + o; h16x4 hv = {(h16)v[0], (h16)v[1], (h16)v[2], (h16)v[3]};
                     *(h16x4*)(O16 + (size_t)row * D + col) = hv; }
            }
        }
    } else if (mode == 4) {
#pragma unroll
      for (int ai = 0; ai < 2; ++ai)
#pragma unroll
        for (int m = 0; m < 4; ++m) {
          int row = brow + ai * 128 + wr * 64 + m * 16 + fr;
          float* xr = xrow2(out, ws, g, row);
          const float* md = modrow2(ws, l, g, row) + goff;
#pragma unroll
          for (int bj = 0; bj < 2; ++bj)
#pragma unroll
            for (int n = 0; n < 2; ++n) {
              int col = bcol + bj * 128 + wc * 32 + n * 16 + fq * 4;
              f32x4 gt = *(const f32x4*)(md + col);
              f32x4 o = *(f32x4*)(xr + col);
              *(f32x4*)(xr + col) = o + gt * acc[ai][bj][m][n];
            }
        }
    } else {
      int hb = (bcol >> 8) * 128;
#pragma unroll
      for (int ai = 0; ai < 2; ++ai)
#pragma unroll
        for (int m = 0; m < 4; ++m) {
          int row = brow + ai * 128 + wr * 64 + m * 16 + fr;
#pragma unroll
          for (int n = 0; n < 2; ++n) {
            int col = hb + wc * 32 + n * 16 + fq * 4;
            f32x4 a = acc[ai][0][m][n], b = acc[ai][1][m][n];
            h16x4 o;
#pragma unroll
            for (int j = 0; j < 4; ++j) o[j] = (h16)(siluf_(a[j]) * b[j]);
            *(h16x4*)(O16 + (size_t)row * DFF + col) = o;
          }
        }
    }
  }
};

__device__ void phase_mod(CP4& p, float* sm) {
  float* SC = sm;
  float* RED = sm + 17 * 1024;
  int tid = threadIdx.x;
  for (int u = blockIdx.x; u < 4 * 48; u += gridDim.x) {
    int l = u / 48, cb = (u % 48) * 128;
    __syncthreads();
    for (int e = tid; e < 17 * 1024; e += NTHREADS) {
      int i = e >> 10, k = e & 1023;
      float c = (i < 16) ? p.in[1][i * 1024 + k] : p.in[3][k];
      SC[e] = siluf_(c);
    }
    __syncthreads();
    int cj = tid & 127, kq = tid >> 7;
    const float* W = p.in[4] + (size_t)l * 1024 * 6144 + cb + cj;
    float acc[17];
#pragma unroll
    for (int i = 0; i < 17; ++i) acc[i] = 0.f;
    for (int k = kq * 256; k < kq * 256 + 256; k += 4) {
      float w0 = W[(size_t)k * 6144], w1 = W[(size_t)(k + 1) * 6144], w2 = W[(size_t)(k + 2) * 6144], w3 = W[(size_t)(k + 3) * 6144];
#pragma unroll
      for (int i = 0; i < 17; ++i) {
        float4 s = *(const float4*)(SC + i * 1024 + k);
        acc[i] += s.x * w0 + s.y * w1 + s.z * w2 + s.w * w3;
      }
    }
#pragma unroll
    for (int i = 0; i < 17; ++i) RED[(kq * 17 + i) * 128 + cj] = acc[i];
    __syncthreads();
    if (kq == 0) {
      float* MO = (float*)(p.ws + OFF_MOD);
      float b = p.in[5][l * 6144 + cb + cj];
#pragma unroll
      for (int i = 0; i < 17; ++i) {
        float v = RED[(0 * 17 + i) * 128 + cj] + RED[(1 * 17 + i) * 128 + cj] + RED[(2 * 17 + i) * 128 + cj] + RED[(3 * 17 + i) * 128 + cj];
        MO[((size_t)l * 17 + i) * 6144 + cb + cj] = v + b;
      }
    }
  }
}

__device__ void phase_copyx(CP4& p) {
  size_t n1 = (size_t)NB * SEQ * D / 4, n2 = (size_t)NB * CTX * D / 4;
  const float4* s1 = (const float4*)p.in[0]; float4* d1 = (float4*)p.out;
  const float4* s2 = (const float4*)p.in[2]; float4* d2 = (float4*)(p.ws + OFF_CTXX);
  size_t stride = (size_t)gridDim.x * NTHREADS;
  for (size_t i = (size_t)blockIdx.x * NTHREADS + threadIdx.x; i < n1; i += stride) d1[i] = s1[i];
  for (size_t i = (size_t)blockIdx.x * NTHREADS + threadIdx.x; i < n2; i += stride) d2[i] = s2[i];
}

__device__ void tr_job(const float* src, int K, int Nsrc, h16* dst, int Ndst, int mode, float* T) {
  int tk = K / 64, tn = Ndst / 64;
  int tid = threadIdx.x, ty = tid >> 6, tx = tid & 63;
  for (int u = blockIdx.x; u < tk * tn; u += gridDim.x) {
    int k0 = (u % tk) * 64, n0 = (u / tk) * 64;
    int sn0;
    if (mode == 1) { int pn = n0 >> 8, j = n0 & 255; sn0 = (j < 128) ? pn * 128 + j : DFF + pn * 128 + (j - 128); }
    else sn0 = n0;
    bool valid = sn0 < Nsrc;
    __syncthreads();
#pragma unroll
    for (int i = 0; i < 8; ++i) {
      int kk = ty + 8 * i;
      T[kk * 65 + tx] = valid ? src[(size_t)(k0 + kk) * Nsrc + sn0 + tx] : 0.f;
    }
    __syncthreads();
#pragma unroll
    for (int i = 0; i < 8; ++i) {
      int nn = ty + 8 * i;
      dst[(size_t)(n0 + nn) * K + k0 + tx] = (h16)T[tx * 65 + nn];
    }
  }
}
__device__ void phase_convert(CP4& p, int l, float* sm) {
  tr_job(p.in[8] + (size_t)l * D * PIN, D, PIN, (h16*)(p.ws + OFF_WINT), PINP, 0, sm);
  tr_job(p.in[32] + (size_t)l * D * 2 * DFF, D, 2 * DFF, (h16*)(p.ws + OFF_FFNINT), 2 * DFF, 1, sm);
  tr_job(p.in[33] + (size_t)l * DFF * D, DFF, D, (h16*)(p.ws + OFF_FFNOUTT), D, 0, sm);
  tr_job(p.in[20] + (size_t)l * D * D, D, D, (h16*)(p.ws + OFF_ROUTT), D, 0, sm);
  tr_job(p.in[31] + (size_t)l * D * D, D, D, (h16*)(p.ws + OFF_WMT), D, 0, sm);
  tr_job(p.in[25] + (size_t)l * 512 * D, 512, D, (h16*)(p.ws + OFF_COUTT), D, 0, sm);
  tr_job(p.in[30] + (size_t)l * 512 * D, 512, D, (h16*)(p.ws + OFF_SOUTT), D, 0, sm);
  const float* sw = p.in[28] + (size_t)l * 8 * 128 * 128;
  h16* dw = (h16*)(p.ws + OFF_SGUW);
  for (int i = blockIdx.x * NTHREADS + threadIdx.x; i < 8 * 128 * 128; i += gridDim.x * NTHREADS) dw[i] = (h16)sw[i];
}

__device__ void phase_norm(CP4& p, int l, int g, int which, int nrows) {
  const float* gam = p.in[which ? 7 : 6] + l * D;
  h16* H = (h16*)(p.ws + OFF_H);
  int lane = threadIdx.x & 63, wv = threadIdx.x >> 6;
  for (int r = blockIdx.x * 8 + wv; r < nrows; r += gridDim.x * 8) {
    const float* x = xrow(p, g, r);
    const float* md = modrow(p, l, g, r) + which * 3072;
    f32x4 v[4]; float ss = 0.f;
#pragma unroll
    for (int i = 0; i < 4; ++i) { v[i] = *(const f32x4*)(x + i * 256 + lane * 4); ss += v[i][0] * v[i][0] + v[i][1] * v[i][1] + v[i][2] * v[i][2] + v[i][3] * v[i][3]; }
    ss = wave_sum(ss);
    float rs = rsqrtf(ss * (1.0f / D) + 1e-6f);
#pragma unroll
    for (int i = 0; i < 4; ++i) {
      int c = i * 256 + lane * 4;
      f32x4 gm = *(const f32x4*)(gam + c), sh = *(const f32x4*)(md + c), sc = *(const f32x4*)(md + D + c);
      h16x4 o;
#pragma unroll
      for (int j = 0; j < 4; ++j) o[j] = (h16)((v[i][j] * rs * gm[j]) * (1.0f + sc[j]) + sh[j]);
      *(h16x4*)(H + (size_t)r * D + c) = o;
    }
  }
}

__device__ void phase_final(CP4& p) {
  const float* gam = p.in[34];
  int lane = threadIdx.x & 63, wv = threadIdx.x >> 6;
  for (int r = blockIdx.x * 8 + wv; r < NB * SEQ; r += gridDim.x * 8) {
    float* x = p.out + (size_t)r * D;
    f32x4 v[4]; float ss = 0.f;
#pragma unroll
    for (int i = 0; i < 4; ++i) { v[i] = *(const f32x4*)(x + i * 256 + lane * 4); ss += v[i][0] * v[i][0] + v[i][1] * v[i][1] + v[i][2] * v[i][2] + v[i][3] * v[i][3]; }
    ss = wave_sum(ss);
    float rs = rsqrtf(ss * (1.0f / D) + 1e-6f);
#pragma unroll
    for (int i = 0; i < 4; ++i) {
      int c = i * 256 + lane * 4;
      f32x4 gm = *(const f32x4*)(gam + c);
      f32x4 o = v[i] * rs * gm;
      *(f32x4*)(x + c) = o;
    }
  }
}

constexpr int TC = 32;
__device__ void scan_pair(CP4& p, int l, int bl, int hh, float* sm) {
  const h16* Z = (const h16*)(p.ws + OFF_Z);
  float* Y = (float*)(p.ws + OFF_Y);
  const float* sw = p.in[9] + (size_t)l * 3 * RC;
  int tid = threadIdx.x, lane = tid & 63, wv = tid >> 6, d = wv >> 2, wq = wv & 3;
  float* A0 = sm + d * (6 * TC * 64);
  float* A1 = A0 + TC * 64;
  float* A2 = A1 + TC * 64;
  float* A3 = A2 + TC * 64;
  float* A4 = A3 + TC * 64;
  float* A5 = A4 + TC * 64;
  const float* w0 = p.in[10] + ((size_t)l * 2 + d) * D + hh * 64;
  const float* a0 = p.in[12] + ((size_t)l * 2 + d) * D + hh * 64;
  const float* wup = p.in[11] + ((size_t)l * 2 + d) * 64 * D + hh * 64;
  const float* aup = p.in[13] + ((size_t)l * 2 + d) * 64 * D + hh * 64;
  const float kkc = p.in[15][l * D + hh * 64 + lane];
  const float kac = p.in[16][l * D + hh * 64 + lane];
  const float w0l = w0[lane], a0l = a0[lane];
  const int i16 = lane & 15, q = lane >> 4;
  float S[16];
#pragma unroll
  for (int n = 0; n < 16; ++n) S[n] = 0.f;
  const int NCH = (CTX + SEQ) / TC;
  for (int c = 0; c < NCH; ++c) {
    int L, t0, rbase;
    if (c < CTX / TC) { L = CTX; t0 = d ? (CTX - TC * (c + 1)) : TC * c; rbase = MLAT + bl * CTX; }
    else { int cc = c - CTX / TC; L = SEQ; t0 = d ? (SEQ - TC * (cc + 1)) : TC * cc; rbase = bl * SEQ; }
    for (int idx = wq; idx < TC * 5; idx += 4) {
      int tok = idx / 5, seg = idx % 5;
      int col = (seg < 3) ? seg * D + hh * 64 + lane : (seg == 3 ? 3072 + d * 64 + lane : 3200 + d * 64 + lane);
      int t = t0 + tok;
      float v = zshift(Z, sw, rbase + t, t, L, col);
      if (seg == 3) v = tanhf(v);
      A0[seg * TC * 64 + tok * 64 + lane] = v;
    }
    __syncthreads();
    {
      float accw[8], acca[8];
#pragma unroll
      for (int tt = 0; tt < 8; ++tt) { accw[tt] = w0l; acca[tt] = a0l; }
      for (int i = 0; i < 64; i += 4) {
        float wu0 = wup[(size_t)i * D + lane], wu1 = wup[(size_t)(i + 1) * D + lane], wu2 = wup[(size_t)(i + 2) * D + lane], wu3 = wup[(size_t)(i + 3) * D + lane];
        float au0 = aup[(size_t)i * D + lane], au1 = aup[(size_t)(i + 1) * D + lane], au2 = aup[(size_t)(i + 2) * D + lane], au3 = aup[(size_t)(i + 3) * D + lane];
#pragma unroll
        for (int tt = 0; tt < 8; ++tt) {
          int tok = wq * 8 + tt;
          float4 lw = *(const float4*)(A3 + tok * 64 + i);
          float4 la = *(const float4*)(A4 + tok * 64 + i);
          accw[tt] += lw.x * wu0 + lw.y * wu1 + lw.z * wu2 + lw.w * wu3;
          acca[tt] += la.x * au0 + la.y * au1 + la.z * au2 + la.w * au3;
        }
      }
#pragma unroll
      for (int tt = 0; tt < 8; ++tt) {
        int tok = wq * 8 + tt;
        float lw = accw[tt];
        float nl = -lw;
        float sp = fmaxf(nl, 0.f) + log1pf(__expf(-fabsf(nl)));
        float e = __expf(-sp - 0.5f);
        float dec = __expf(-e);
        float a = sigmoidf_(acca[tt]);
        float kraw = A1[tok * 64 + lane];
        float kkv = kraw * kkc;
        float ss = wave_sum(kkv * kkv);
        float kk = kkv * rsqrtf(fmaxf(ss, 1e-24f));
        float kd = kraw * (1.0f + (a - 1.0f) * kac);
        A3[tok * 64 + lane] = dec;
        A1[tok * 64 + lane] = kd;
        A5[tok * 64 + lane] = kk;
        A4[tok * 64 + lane] = kk * a;
      }
    }
    __syncthreads();
    for (int s = 0; s < TC; ++s) {
      int tok = d ? (TC - 1 - s) : s;
      const float* bw = A3 + tok * 64 + q * 16;
      const float* bk = A1 + tok * 64 + q * 16;
      const float* bkk = A5 + tok * 64 + q * 16;
      const float* bka = A4 + tok * 64 + q * 16;
      const float* br = A0 + tok * 64 + q * 16;
      float vv = A2[tok * 64 + wq * 16 + i16];
      float sa = 0.f;
#pragma unroll
      for (int n4 = 0; n4 < 4; ++n4) {
        float4 k4 = *(const float4*)(bkk + n4 * 4);
        sa += S[n4 * 4] * k4.x + S[n4 * 4 + 1] * k4.y + S[n4 * 4 + 2] * k4.z + S[n4 * 4 + 3] * k4.w;
      }
      sa += __shfl_xor(sa, 16, 64);
      sa += __shfl_xor(sa, 32, 64);
      float y = 0.f;
#pragma unroll
      for (int n4 = 0; n4 < 4; ++n4) {
        float4 w4 = *(const float4*)(bw + n4 * 4);
        float4 kd4 = *(const float4*)(bk + n4 * 4);
        float4 ka4 = *(const float4*)(bka + n4 * 4);
        float4 r4 = *(const float4*)(br + n4 * 4);
        S[n4 * 4 + 0] = S[n4 * 4 + 0] * w4.x + (vv * kd4.x - sa * ka4.x);
        S[n4 * 4 + 1] = S[n4 * 4 + 1] * w4.y + (vv * kd4.y - sa * ka4.y);
        S[n4 * 4 + 2] = S[n4 * 4 + 2] * w4.z + (vv * kd4.z - sa * ka4.z);
        S[n4 * 4 + 3] = S[n4 * 4 + 3] * w4.w + (vv * kd4.w - sa * ka4.w);
        y += S[n4 * 4] * r4.x + S[n4 * 4 + 1] * r4.y + S[n4 * 4 + 2] * r4.z + S[n4 * 4 + 3] * r4.w;
      }
      y += __shfl_xor(y, 16, 64);
      y += __shfl_xor(y, 32, 64);
      if (q == 0) Y[((size_t)d * MG + rbase + t0 + tok) * D + hh * 64 + wq * 16 + i16] = y;
    }
    __syncthreads();
  }
}

__device__ void conv_unit(CP4& p, int l, int rowbase, int stride, int L, int p0, char* smc) {
  const h16* Z = (const h16*)(p.ws + OFF_Z);
  h16* BP = (h16*)(p.ws + OFF_BPRE);
  h16* U = (h16*)smc;
  float* Yc = (float*)(smc + 62 * 512 * 2);
  int tid = threadIdx.x, lane = tid & 63, wv = tid >> 6;
  __syncthreads();
  for (int pp = wv; pp < 62; pp += 8) {
    int pos = p0 - 15 + pp;
    h16x8 o;
    if (pos >= 0 && pos < L) {
      size_t r = (size_t)(rowbase + pos * stride);
      h16x8 a = *(const h16x8*)(Z + r * PINP + OFF_CONV + lane * 8);
      h16x8 b = *(const h16x8*)(Z + r * PINP + OFF_CONV + 512 + lane * 8);
#pragma unroll
      for (int j = 0; j < 8; ++j) o[j] = (h16)((float)a[j] * sigmoidf_((float)b[j]));
    } else {
#pragma unroll
      for (int j = 0; j < 8; ++j) o[j] = (h16)0.f;
    }
    *(h16x8*)(U + pp * 512 + lane * 8) = o;
  }
  __syncthreads();
  {
    const float* dw = p.in[21] + (size_t)l * 31 * 512 + tid;
    float w[31];
#pragma unroll
    for (int j = 0; j < 31; ++j) w[j] = dw[j * 512];
    float bias = p.in[22][l * 512 + tid];
    for (int pp = 0; pp < 32; ++pp) {
      float acc = bias;
#pragma unroll
      for (int j = 0; j < 31; ++j) acc += (float)U[(pp + j) * 512 + tid] * w[j];
      Yc[pp * 512 + tid] = acc;
    }
  }
  __syncthreads();
  const float* lg = p.in[23] + l * 512 + lane * 8;
  const float* lb = p.in[24] + l * 512 + lane * 8;
  for (int pp = wv; pp < 32; pp += 8) {
    float v[8]; float s = 0.f;
#pragma unroll
    for (int j = 0; j < 8; ++j) { v[j] = Yc[pp * 512 + lane * 8 + j]; s += v[j]; }
    float mean = wave_sum(s) * (1.0f / 512);
    float s2 = 0.f;
#pragma unroll
    for (int j = 0; j < 8; ++j) { v[j] -= mean; s2 += v[j] * v[j]; }
    float rstd = rsqrtf(wave_sum(s2) * (1.0f / 512) + 1e-5f);
    h16x8 o;
#pragma unroll
    for (int j = 0; j < 8; ++j) { float t = v[j] * rstd * lg[j] + lb[j]; o[j] = (h16)siluf_(t); }
    size_t r = (size_t)(rowbase + (p0 + pp) * stride);
    *(h16x8*)(BP + r * 512 + lane * 8) = o;
  }
}

__device__ void sgu_unit(CP4& p, int l, int row0, char* smc) {
  const h16* Z = (const h16*)(p.ws + OFF_Z);
  h16* CP = (h16*)(p.ws + OFF_CPRE);
  const h16* SW = (const h16*)(p.ws + OFF_SGUW);
  float* MEAN = (float*)smc;
  float* RSTD = MEAN + 128;
  h16* VT = (h16*)(smc + 1024);
  int tid = threadIdx.x, lane = tid & 63, wv = tid >> 6;
  __syncthreads();
  for (int tk = wv; tk < 128; tk += 8) {
    h16x8 a = *(const h16x8*)(Z + (size_t)(row0 + tk) * PINP + OFF_SGU + 512 + lane * 8);
    float v[8]; float s = 0.f;
#pragma unroll
    for (int j = 0; j < 8; ++j) { v[j] = geluf_((float)a[j]); s += v[j]; }
    float mean = wave_sum(s) * (1.0f / 512);
    float s2 = 0.f;
#pragma unroll
    for (int j = 0; j < 8; ++j) { float dd = v[j] - mean; s2 += dd * dd; }
    float rstd = rsqrtf(wave_sum(s2) * (1.0f / 512) + 1e-5f);
    if (lane == 0) { MEAN[tk] = mean; RSTD[tk] = rstd; }
  }
  __syncthreads();
  const float* lg = p.in[26] + l * 512;
  const float* lb = p.in[27] + l * 512;
  const float* bs = p.in[29] + (size_t)l * 8 * 128;
  int fr = lane & 15, fq = lane >> 4;
  for (int g = 0; g < 8; ++g) {
    {
      int qk = tid >> 2, d0 = (tid & 3) * 16;
      float mean = MEAN[qk], rstd = RSTD[qk];
      const h16* src = Z + (size_t)(row0 + qk) * PINP + OFF_SGU + 512 + g * 64 + d0;
      h16x8 a0 = *(const h16x8*)src, a1 = *(const h16x8*)(src + 8);
#pragma unroll
      for (int j = 0; j < 8; ++j) {
        int c0 = g * 64 + d0 + j, c1 = c0 + 8;
        float v0 = (geluf_((float)a0[j]) - mean) * rstd * lg[c0] + lb[c0];
        float v1 = (geluf_((float)a1[j]) - mean) * rstd * lg[c1] + lb[c1];
        VT[(d0 + j) * 136 + qk] = (h16)v0;
        VT[(d0 + j + 8) * 136 + qk] = (h16)v1;
      }
    }
    __syncthreads();
    f32x4 acc[4];
#pragma unroll
    for (int dt = 0; dt < 4; ++dt) acc[dt] = (f32x4){0.f, 0.f, 0.f, 0.f};
#pragma unroll
    for (int ks = 0; ks < 4; ++ks) {
      h16x8 af = *(const h16x8*)(SW + ((size_t)g * 128 + wv * 16 + fr) * 128 + ks * 32 + fq * 8);
#pragma unroll
      for (int dt = 0; dt < 4; ++dt) {
        h16x8 bf = *(const h16x8*)(VT + (dt * 16 + fr) * 136 + ks * 32 + fq * 8);
        acc[dt] = __builtin_amdgcn_mfma_f32_16x16x32_f16(af, bf, acc[dt], 0, 0, 0);
      }
    }
#pragma unroll
    for (int dt = 0; dt < 4; ++dt)
#pragma unroll
      for (int j = 0; j < 4; ++j) {
        int pr = wv * 16 + fq * 4 + j, dd = dt * 16 + fr;
        float val = acc[dt][j] + bs[g * 128 + pr];
        float u = geluf_((float)Z[(size_t)(row0 + pr) * PINP + OFF_SGU + g * 64 + dd]);
        CP[(size_t)(row0 + pr) * 512 + g * 64 + dd] = (h16)(u * val);
      }
    __syncthreads();
  }
}

__device__ void phase_mix(CP4& p, int l, int g, char* smc) {
  const bool last = (l == DEPTH - 1);
  const int NSCAN = GB * 16;
  if ((int)blockIdx.x < NSCAN) {
    scan_pair(p, l, blockIdx.x >> 4, blockIdx.x & 15, (float*)smc);
    return;
  }
  int nb = gridDim.x - NSCAN, bi = blockIdx.x - NSCAN;
  int nconv_lat = GB * 64, nconv = nconv_lat + (last ? 0 : GB * 8);
  for (int u = bi; u < nconv; u += nb) {
    if (u < nconv_lat) {
      int bl = u >> 6, w = u & 63;
      if ((l & 1) == 0) conv_unit(p, l, bl * SEQ + (w >> 1) * 64, 1, 64, (w & 1) * 32, smc);
      else conv_unit(p, l, bl * SEQ + w, 64, 32, 0, smc);
    } else {
      int uu = u - nconv_lat, bl = uu >> 3, sg = uu & 7;
      conv_unit(p, l, MLAT + bl * CTX, 1, CTX, sg * 32, smc);
    }
  }
  int nsgu = last ? MLAT / 128 : MG / 128;
  for (int u = bi; u < nsgu; u += nb) sgu_unit(p, l, u * 128, smc);
}

__device__ void phase_postscan(CP4& p, int l, int g, float* sm) {
  const bool last = (l == DEPTH - 1);
  const h16* Z = (const h16*)(p.ws + OFF_Z);
  const float* Y = (const float*)(p.ws + OFF_Y);
  h16* AP = (h16*)(p.ws + OFF_APRE);
  const float* sw = p.in[9] + (size_t)l * 3 * RC;
  const float* gup = p.in[14] + (size_t)l * 128 * D;
  float* SG = sm;
  float* G = sm + 16 * 128;
  int tid = threadIdx.x, lane = tid & 63, wv = tid >> 6;
  int ntiles = (last ? MLAT : MG) / 16;
  for (int u = blockIdx.x; u < ntiles; u += gridDim.x) {
    int row0 = u * 16;
    __syncthreads();
    for (int e = tid; e < 16 * 128; e += NTHREADS) {
      int tok = e >> 7, k = e & 127;
      int r = row0 + tok, t, L; seqpos(r, t, L);
      SG[e] = sigmoidf_(zshift(Z, sw, r, t, L, 3328 + k));
    }
    __syncthreads();
    {
      float a0[16], a1[16];
#pragma unroll
      for (int i = 0; i < 16; ++i) { a0[i] = 0.f; a1[i] = 0.f; }
      for (int k = 0; k < 128; k += 4) {
        float g00 = gup[(size_t)k * D + tid], g01 = gup[(size_t)(k + 1) * D + tid], g02 = gup[(size_t)(k + 2) * D + tid], g03 = gup[(size_t)(k + 3) * D + tid];
        float g10 = gup[(size_t)k * D + tid + 512], g11 = gup[(size_t)(k + 1) * D + tid + 512], g12 = gup[(size_t)(k + 2) * D + tid + 512], g13 = gup[(size_t)(k + 3) * D + tid + 512];
#pragma unroll
        for (int i = 0; i < 16; ++i) {
          float4 s = *(const float4*)(SG + i * 128 + k);
          a0[i] += s.x * g00 + s.y * g01 + s.z * g02 + s.w * g03;
          a1[i] += s.x * g10 + s.y * g11 + s.z * g12 + s.w * g13;
        }
      }
#pragma unroll
      for (int i = 0; i < 16; ++i) { G[i * 1024 + tid] = a0[i]; G[i * 1024 + tid + 512] = a1[i]; }
    }
    __syncthreads();
    for (int idx = wv; idx < 256; idx += 8) {
      int tok = idx >> 4, hh = idx & 15, col = hh * 64 + lane;
      int r = row0 + tok, t, L; seqpos(r, t, L);
      float y = Y[(size_t)r * D + col] + Y[((size_t)MG + r) * D + col];
      float mean = wave_sum(y) * (1.0f / 64);
      float dd = y - mean;
      float var = wave_sum(dd * dd) * (1.0f / 64);
      float yn = dd * rsqrtf(var + 64e-5f) * p.in[18][l * D + col] + p.in[19][l * D + col];
      float rr = zshift(Z, sw, r, t, L, col);
      float kk = zshift(Z, sw, r, t, L, D + col);
      float vv = zshift(Z, sw, r, t, L, 2 * D + col);
      float bonus = wave_sum(rr * kk * p.in[17][l * D + col]) * vv;
      float o = (float)(h16)(yn + bonus) * G[tok * 1024 + col];
      AP[(size_t)r * D + col] = (h16)o;
    }
  }
}

constexpr int NPHASE = 2 + DEPTH * (1 + NG * 9) + 1;

template <int MODE>
__device__ __forceinline__ void gemm_job(CP4& p, int l, int g, char* smc) {
  const bool last = (l == DEPTH - 1);
  LAS unsigned char* shm = (LAS unsigned char*)smc;
  const int nMr = (last ? MLAT : MG) / BM;
  EpiAny<MODE> e{nullptr, (const h16*)(p.ws + OFF_Z), (float*)(p.ws + OFF_Y), p.out, p.ws, l, g, 0};
  if (MODE == 0) { e.O16 = (h16*)(p.ws + OFF_Z); gemm_phase(shm, (const h16*)(p.ws + OFF_H), (const h16*)(p.ws + OFF_WINT), D, 0, MG / BM, PINP / BM, e); }
  else if (MODE == 1) { gemm_phase(shm, (const h16*)(p.ws + OFF_APRE), (const h16*)(p.ws + OFF_ROUTT), 1024, 0, nMr, D / BM, e); }
  else if (MODE == 2) { gemm_phase(shm, (const h16*)(p.ws + OFF_BPRE), (const h16*)(p.ws + OFF_COUTT), 512, 0, nMr, D / BM, e); }
  else if (MODE == 3) { e.O16 = (h16*)(p.ws + OFF_M16); gemm_phase(shm, (const h16*)(p.ws + OFF_CPRE), (const h16*)(p.ws + OFF_SOUTT), 512, 0, nMr, D / BM, e); }
  else if (MODE == 4) { e.goff = 2048; gemm_phase(shm, (const h16*)(p.ws + OFF_M16), (const h16*)(p.ws + OFF_WMT), D, 0, nMr, D / BM, e); }
  else if (MODE == 5) { e.O16 = (h16*)(p.ws + OFF_Z); gemm_phase(shm, (const h16*)(p.ws + OFF_H), (const h16*)(p.ws + OFF_FFNINT), D, 0, nMr, 2 * DFF / BM, e); }
  else { e.goff = 5120; gemm_phase(shm, (const h16*)(p.ws + OFF_Z), (const h16*)(p.ws + OFF_FFNOUTT), DFF, 0, nMr, D / BM, e); }
}

__device__ __forceinline__ void decode_phase(int ph, int& kind, int& l, int& g, int& st) {
  l = g = st = 0;
  if (ph == 0) { kind = 0; return; }
  if (ph == 1) { kind = 1; return; }
  if (ph == NPHASE - 1) { kind = 2; return; }
  int q = ph - 2; l = q / (1 + NG * 9); int s = q % (1 + NG * 9);
  if (s == 0) { kind = 3; return; }
  s -= 1; kind = 4; g = s / 9; st = s % 9;
}

__device__ __forceinline__ void run_nongemm(CP4& p, int ph, char* smc) {
  int kind, l, g, st; decode_phase(ph, kind, l, g, st);
  const bool last = (l == DEPTH - 1);
  if (kind == 0) phase_mod(p, (float*)smc);
  else if (kind == 1) phase_copyx(p);
  else if (kind == 2) phase_final(p);
  else if (kind == 3) phase_convert(p, l, (float*)smc);
  else {
    if (st == 0) phase_norm(p, l, g, 0, MG);
    else if (st == 2) phase_mix(p, l, g, smc);
    else if (st == 3) phase_postscan(p, l, g, (float*)smc);
    else if (st == 6) phase_norm(p, l, g, 1, last ? MLAT : MG);
  }
}

__global__ void __launch_bounds__(NTHREADS) k_misc(P p, int ph) {
  extern __shared__ __attribute__((aligned(16))) char smc[];
  CP4* pp = (CP4*)__builtin_amdgcn_kernarg_segment_ptr();
  run_nongemm(*pp, ph, smc);
}
template <int MODE>
__global__ void __launch_bounds__(NTHREADS) k_gemm(P p, int l, int g) {
  extern __shared__ __attribute__((aligned(16))) char smc[];
  CP4* pp = (CP4*)__builtin_amdgcn_kernarg_segment_ptr();
  gemm_job<MODE>(*pp, l, g, smc);
}

template <int MODE> static void launch_gemm(const P& p, int l, int g, hipStream_t stream) {
  static bool attr = false;
  if (!attr) { (void)hipFuncSetAttribute((const void*)k_gemm<MODE>, hipFuncAttributeMaxDynamicSharedMemorySize, SHM_BYTES); attr = true; }
  k_gemm<MODE><<<256, NTHREADS, SHM_BYTES, stream>>>(p, l, g);
}

extern "C" void kernel_launch(void* const* d_in, const int* in_sizes, int n_in, void* d_out, int out_size, void* d_ws, size_t ws_size,
                              hipStream_t stream) {
  P p{};
  for (int i = 0; i < 35; ++i) p.in[i] = (const float*)d_in[i];
  p.out = (float*)d_out;
  p.ws = (char*)d_ws;
  static bool attr = false;
  if (!attr) { (void)hipFuncSetAttribute((const void*)k_misc, hipFuncAttributeMaxDynamicSharedMemorySize, SHM_BYTES); attr = true; }
  for (int ph = 0; ph < NPHASE; ++ph) {
    int kind = 4, l = 0, g = 0, st = 0;
    if (ph == 0 || ph == 1 || ph == NPHASE - 1) kind = 0;
    else { int q = ph - 2; l = q / (1 + NG * 9); int s = q % (1 + NG * 9); if (s == 0) kind = 0; else { s -= 1; g = s / 9; st = s % 9; } }
    if (kind == 0 || st == 0 || st == 2 || st == 3 || st == 6) { k_misc<<<256, NTHREADS, SHM_BYTES, stream>>>(p, ph); continue; }
    if (st == 1) launch_gemm<0>(p, l, g, stream);
    else if (st == 4) { launch_gemm<1>(p, l, g, stream); launch_gemm<2>(p, l, g, stream); launch_gemm<3>(p, l, g, stream); }
    else if (st == 5) launch_gemm<4>(p, l, g, stream);
    else if (st == 7) launch_gemm<5>(p, l, g, stream);
    else launch_gemm<6>(p, l, g, stream);
  }
}
```

```cpp
#include <hip/hip_runtime.h>
#include <hip/hip_cooperative_groups.h>
namespace cg = cooperative_groups;

#ifndef REP_SCAN
#define REP_SCAN 1
#endif
#ifndef REP_POST
#define REP_POST 1
#endif
#ifndef REP_CS
#define REP_CS 1
#endif
#ifndef REP_ZR
#define REP_ZR 1
#endif
#ifndef COOP
#define COOP 1
#endif

typedef _Float16 h16;
typedef _Float16 h16x8 __attribute__((ext_vector_type(8)));
typedef _Float16 h16x4 __attribute__((ext_vector_type(4)));
typedef float f32x4 __attribute__((ext_vector_type(4)));
typedef float f32x2 __attribute__((ext_vector_type(2)));

constexpr int D = 1024, NB = 16, SEQ = 2048, DEPTH = 4, CTX = 256;
constexpr int PIN = 8576, PINP = 8704, RC = 3456;
constexpr int ZRW = 3584;
constexpr int ZOW = 5120;
constexpr int OC_CONV = 0, OC_SGU = 1024, OC_GATE = 2048;
constexpr int DFF = 2816;
constexpr int GB = 4, NG = NB / GB;
constexpr int MLAT = GB * SEQ, MCTX = GB * CTX, MG = MLAT + MCTX;
constexpr int NLAT = NB * SEQ, MALL = NB * (SEQ + CTX);
constexpr int NTHREADS = 512;
constexpr int SHM_BYTES = 131072;
constexpr float YSC = 0.0625f, YUN = 16.0f;

constexpr size_t al256(size_t x) { return (x + 255) / 256 * 256; }
constexpr size_t OFF_MOD = 0;
constexpr size_t OFF_BAR = al256(OFF_MOD + (size_t)4 * 17 * 6144 * 4);
constexpr size_t OFF_CTXX = al256(OFF_BAR + 256);
constexpr size_t OFF_WINT = al256(OFF_CTXX + (size_t)NB * CTX * D * 4);
constexpr size_t OFF_FFNINT = al256(OFF_WINT + (size_t)PINP * D * 2);
constexpr size_t OFF_FFNOUTT = al256(OFF_FFNINT + (size_t)2 * DFF * D * 2);
constexpr size_t OFF_ROUTT = al256(OFF_FFNOUTT + (size_t)D * DFF * 2);
constexpr size_t OFF_WMT = al256(OFF_ROUTT + (size_t)D * D * 2);
constexpr size_t OFF_COUTT = al256(OFF_WMT + (size_t)D * D * 2);
constexpr size_t OFF_SOUTT = al256(OFF_COUTT + (size_t)D * 512 * 2);
constexpr size_t OFF_SGUW = al256(OFF_SOUTT + (size_t)D * 512 * 2);
constexpr size_t OFF_GUPT = al256(OFF_SGUW + (size_t)8 * 128 * 128 * 2);
constexpr size_t OFF_HALL = al256(OFF_GUPT + (size_t)D * 128 * 2);
constexpr size_t OFF_YH = al256(OFF_HALL + (size_t)MALL * D * 2);
constexpr size_t OFF_APRE = OFF_YH;
constexpr size_t OFF_ZR = al256(OFF_YH + (size_t)2 * MALL * D * 2);
constexpr size_t OFF_FFNOUTT2 = al256(OFF_ZR + (size_t)MALL * ZRW * 2);
constexpr size_t WS_TOTAL = al256(OFF_FFNOUTT2 + (size_t)D * DFF * 2);
constexpr size_t ZO_BYTES = (size_t)MG * ZOW * 2;
constexpr size_t OFF_ZO = OFF_ZR;
constexpr size_t OFF_BPRE = al256(OFF_ZO + 2 * ZO_BYTES);
constexpr size_t OFF_CPRE = al256(OFF_BPRE + (size_t)MG * 512 * 2);
constexpr size_t OFF_M16 = al256(OFF_CPRE + (size_t)MG * 512 * 2);
constexpr size_t OFF_HID = OFF_ZR;
static_assert(OFF_M16 + (size_t)MG * D * 2 <= OFF_FFNOUTT2, "group buffers must fit in the ZR region");
static_assert(OFF_HID + (size_t)MALL * DFF * 2 <= OFF_FFNOUTT2, "ffn hidden must fit in the ZR region");

struct P {
  const float* in[35];
  float* out;
  char* ws;
};
typedef const __attribute__((address_space(4))) P CP4;

__device__ __forceinline__ float wave_sum(float v) {
#pragma unroll
  for (int m = 32; m >= 1; m >>= 1) v += __shfl_xor(v, m, 64);
  return v;
}
__device__ __forceinline__ int ltid() { int t = threadIdx.x; asm volatile("" : "+v"(t)); return t; }
__device__ __forceinline__ float sigmoidf_(float x) { return __builtin_amdgcn_rcpf(1.0f + __expf(-x)); }
__device__ __forceinline__ float siluf_(float x) { return x * sigmoidf_(x); }
__device__ __forceinline__ float tanhf_(float x) { return 1.0f - 2.0f * __builtin_amdgcn_rcpf(1.0f + __expf(2.0f * x)); }
__device__ __forceinline__ float geluf_(float x) {
  float u = 0.7978845608028654f * (x + 0.044715f * x * x * x);
  return x * __builtin_amdgcn_rcpf(1.0f + __expf(-2.0f * u));
}
__device__ __forceinline__ float* xrow2(float* out, char* ws, int g, int r) {
  return (r < MLAT) ? out + ((size_t)g * MLAT + r) * D
                    : (float*)(ws + OFF_CTXX) + ((size_t)g * MCTX + (r - MLAT)) * D;
}
__device__ __forceinline__ const float* modrow2(const char* ws, int l, int g, int r) {
  int i = (r < MLAT) ? (g * GB + r / SEQ) : 16;
  return (const float*)(ws + OFF_MOD) + ((size_t)l * 17 + i) * 6144;
}
__device__ __forceinline__ float* xrow(CP4& p, int g, int r) { return xrow2(p.out, p.ws, g, r); }
__device__ __forceinline__ const float* modrow(CP4& p, int l, int g, int r) { return modrow2(p.ws, l, g, r); }
__device__ __forceinline__ void seqposG(int R, int& t, int& L) {
  int lr = R % MG;
  if (lr < MLAT) { t = lr % SEQ; L = SEQ; } else { t = (lr - MLAT) % CTX; L = CTX; }
}
__device__ __forceinline__ float zshift(const h16* Z, const float* sw, int r, int t, int L, int col) {
  float v = (float)Z[(size_t)r * ZRW + col] * sw[RC + col];
  if (t > 0) v += (float)Z[(size_t)(r - 1) * ZRW + col] * sw[col];
  if (t < L - 1) v += (float)Z[(size_t)(r + 1) * ZRW + col] * sw[2 * RC + col];
  return v;
}
__device__ __forceinline__ void grid_bar(unsigned* ctr, unsigned target) {
  asm volatile("s_waitcnt vmcnt(0) lgkmcnt(0)" ::: "memory");
  __syncthreads();
  if (threadIdx.x == 0) {
    __builtin_amdgcn_fence(__ATOMIC_RELEASE, "agent");
    asm volatile("s_waitcnt vmcnt(0)" ::: "memory");
    __hip_atomic_fetch_add(ctr, 1u, __ATOMIC_RELAXED, __HIP_MEMORY_SCOPE_AGENT);
    while (__hip_atomic_load(ctr, __ATOMIC_RELAXED, __HIP_MEMORY_SCOPE_AGENT) < target) __builtin_amdgcn_s_sleep(1);
    __builtin_amdgcn_fence(__ATOMIC_ACQUIRE, "agent");
    asm volatile("s_waitcnt vmcnt(0)" ::: "memory");
  }
  __syncthreads();
}

#define LAS __attribute__((address_space(3)))
constexpr int BM = 256, BK = 64, HALF = 128, HTB = HALF * BK * 2;
__device__ __forceinline__ int lds_byte(int r, int c) {
  int st = (r >> 4) * 2 + (c >> 5), rr = r & 15, cc = c & 31, ob = rr * 64 + cc * 2;
  return st * 1024 + (ob ^ (((ob >> 9) & 1) << 5));
}
__device__ __forceinline__ void stage_rc(int b, int& R, int& C) {
  int st = b / 1024, sb = b % 1024, swz = sb ^ (((sb >> 9) & 1) << 5);
  R = (st >> 1) * 16 + swz / 64; C = (st & 1) * 32 + (swz % 64) / 2;
}
__device__ __forceinline__ bool tile_of(int i, int nM, int nN, int ubeg, int uend, int brot, int nblk, int& pm, int& pn) {
  const int NXCD = 8, WGM = 8;
  int nwg = nM * nN;
  int bsub = (int)blockIdx.x - brot; if (bsub < 0) bsub += gridDim.x;
  if (bsub >= nblk) return false;
  long Lq = (long)ubeg + (long)i * nblk + bsub; if (Lq >= uend) return false;
  int wgid = (int)Lq;
  { int q = nwg / NXCD, r = nwg % NXCD, xcd = wgid % NXCD, off = wgid / NXCD;
    wgid = (xcd < r ? xcd * (q + 1) : r * (q + 1) + (xcd - r) * q) + off; }
  int nig = WGM * nN, gid = wgid / nig, fm = gid * WGM, gsz = min(nM - fm, WGM);
  pm = fm + ((wgid % nig) % gsz); pn = (wgid % nig) / gsz;
  return true;
}

template <class Epi>
__device__ __forceinline__ void gemm_phase(LAS unsigned char* lds, const h16* Ag, const h16* Btg, int K, int row0, int nM, int nN, int ubeg, int uend, int brot, int nblk, const Epi& E) {
  const int tid = threadIdx.x, wid = __builtin_amdgcn_readfirstlane(tid >> 6), lane = tid & 63, wr = wid >> 2, wc = wid & 3, fr = lane & 15, fq = lane >> 4;
  const int nt = K / BK;
  unsigned voffA[2];
#pragma unroll
  for (int i = 0; i < 2; ++i) { int R, C; stage_rc(tid * 16 + i * 8192, R, C); voffA[i] = (unsigned)(R * K + C) * 2u; }
  const size_t kstep = (size_t)(BK * 2);
  const size_t hstep = (size_t)HALF * K * 2;
  const size_t tstep = 2 * hstep;
  const unsigned ldsw = (unsigned)wid * 1024u;
  const int aoff = lds_byte(wr * 64 + fr, fq * 8), boff = lds_byte(wc * 32 + fr, fq * 8);
  const char* Abase = (const char*)(Ag + (size_t)row0 * K);
#define PG8_SA(b, h) (((b) * 2 + (h)) * HTB)
#define PG8_SB(b, h) ((4 + (b) * 2 + (h)) * HTB)
#define PG8_STAGE(bufoff, gbase, voff) do { _Pragma("unroll") for (int _i = 0; _i < 2; ++_i) \
    __builtin_amdgcn_global_load_lds((const unsigned*)((const char*)(gbase) + (voff)[_i]), (LAS unsigned*)(lds + (bufoff) + ldsw + _i * 8192), 16, 0, 0); } while (0)
#define PG8_LDA(dst, b, h) do { _Pragma("unroll") for (int m = 0; m < 4; ++m) _Pragma("unroll") for (int k = 0; k < 2; ++k) dst[m][k] = *(const LAS h16x8*)(lds + PG8_SA(b, h) + aoff + m * 2048 + k * 1024); } while (0)
#define PG8_LDB(dst, b, h) do { _Pragma("unroll") for (int n = 0; n < 2; ++n) _Pragma("unroll") for (int k = 0; k < 2; ++k) dst[n][k] = *(const LAS h16x8*)(lds + PG8_SB(b, h) + boff + n * 2048 + k * 1024); } while (0)
#define PG8_MMA(ai, bj, At, Bt) do { __builtin_amdgcn_s_setprio(1); _Pragma("unroll") for (int m = 0; m < 4; ++m) _Pragma("unroll") for (int n = 0; n < 2; ++n) _Pragma("unroll") for (int k = 0; k < 2; ++k) \
    acc[ai][bj][m][n] = __builtin_amdgcn_mfma_f32_16x16x32_f16(Bt[n][k], At[m][k], acc[ai][bj][m][n], 0, 0, 0); __builtin_amdgcn_s_setprio(0); } while (0)
#define PG8_WAIT_V(n) asm volatile("s_waitcnt vmcnt(" #n ")" ::: "memory")
#define PG8_WAIT_L(n) asm volatile("s_waitcnt lgkmcnt(" #n ")" ::: "memory")
#define PG8_BAR __builtin_amdgcn_s_barrier()
#define PG8_SCHED __builtin_amdgcn_sched_barrier(0)
  int cpm, cpn, npm, npn, ui = 0;
  __syncthreads();
  if (!tile_of(0, nM, nN, ubeg, uend, brot, nblk, cpm, cpn)) return;
  f32x4 acc[2][2][4][2];
#pragma unroll
  for (int a = 0; a < 2; ++a)
#pragma unroll
    for (int b = 0; b < 2; ++b)
#pragma unroll
      for (int m = 0; m < 4; ++m)
#pragma unroll
        for (int n = 0; n < 2; ++n) acc[a][b][m][n] = (f32x4){0.f, 0.f, 0.f, 0.f};
  h16x8 At[4][2], B0[2][2], B1[2][2];
  const char* cA = Abase + (size_t)cpm * tstep; const char* cB = (const char*)Btg + (size_t)cpn * tstep;
  PG8_STAGE(PG8_SB(0, 0), cB, voffA); PG8_STAGE(PG8_SA(0, 0), cA, voffA); PG8_STAGE(PG8_SB(0, 1), cB + hstep, voffA); PG8_STAGE(PG8_SA(0, 1), cA + hstep, voffA);
  if (wr == 1) PG8_BAR;
  PG8_WAIT_V(4); PG8_BAR;
  PG8_STAGE(PG8_SB(1, 0), cB + kstep, voffA); PG8_STAGE(PG8_SA(1, 0), cA + kstep, voffA); PG8_STAGE(PG8_SB(1, 1), cB + hstep + kstep, voffA);
  PG8_WAIT_V(6); PG8_BAR;
  for (;;) {
    const bool has_next = tile_of(ui + 1, nM, nN, ubeg, uend, brot, nblk, npm, npn);
    const char* nA = has_next ? Abase + (size_t)npm * tstep : cA; const char* nB = has_next ? (const char*)Btg + (size_t)npn * tstep : cB;
    for (int t = 0; t < nt; t += 2) {
      const bool last = (t == nt - 2);
      const char* a1 = cA + (size_t)(t + 1) * kstep;
      const char* a2 = last ? nA : cA + (size_t)(t + 2) * kstep; const char* b2 = last ? nB : cB + (size_t)(t + 2) * kstep;
      const char* a3 = a2 + kstep; const char* b3 = b2 + kstep;
      PG8_LDB(B0, 0, 0); PG8_SCHED; PG8_LDA(At, 0, 0); PG8_STAGE(PG8_SA(1, 1), a1 + hstep, voffA);
      PG8_WAIT_L(8); PG8_BAR; PG8_WAIT_L(0); PG8_MMA(0, 0, At, B0); PG8_BAR; PG8_SCHED;
      PG8_LDB(B1, 0, 1); PG8_STAGE(PG8_SB(0, 0), b2, voffA);
      PG8_BAR; PG8_WAIT_L(0); PG8_MMA(0, 1, At, B1); PG8_BAR;
      PG8_LDA(At, 0, 1); PG8_STAGE(PG8_SA(0, 0), a2, voffA);
      PG8_BAR; PG8_WAIT_L(0); PG8_MMA(1, 0, At, B0); PG8_BAR; PG8_SCHED;
      PG8_STAGE(PG8_SB(0, 1), b2 + hstep, voffA);
      PG8_WAIT_V(6); PG8_BAR; PG8_MMA(1, 1, At, B1); PG8_BAR;
      PG8_LDB(B0, 1, 0); PG8_SCHED; PG8_LDA(At, 1, 0); PG8_STAGE(PG8_SA(0, 1), a2 + hstep, voffA);
      PG8_WAIT_L(8); PG8_BAR; PG8_WAIT_L(0); PG8_MMA(0, 0, At, B0); PG8_BAR; PG8_SCHED;
      PG8_LDB(B1, 1, 1); PG8_STAGE(PG8_SB(1, 0), b3, voffA);
      PG8_BAR; PG8_WAIT_L(0); PG8_MMA(0, 1, At, B1); PG8_BAR;
      PG8_LDA(At, 1, 1); PG8_STAGE(PG8_SA(1, 0), a3, voffA);
      PG8_BAR; PG8_WAIT_L(0); PG8_MMA(1, 0, At, B0); PG8_BAR; PG8_SCHED;
      PG8_STAGE(PG8_SB(1, 1), b3 + hstep, voffA);
      PG8_WAIT_V(6); PG8_BAR; PG8_MMA(1, 1, At, B1); PG8_BAR;
    }
    E(acc, row0 + cpm * BM, cpn * BM, wr, wc, fr, fq);
    if (!has_next) break;
#pragma unroll
    for (int a = 0; a < 2; ++a)
#pragma unroll
      for (int b = 0; b < 2; ++b)
#pragma unroll
        for (int m = 0; m < 4; ++m)
#pragma unroll
          for (int n = 0; n < 2; ++n) acc[a][b][m][n] = (f32x4){0.f, 0.f, 0.f, 0.f};
    cpm = npm; cpn = npn; cA = nA; cB = nB; ++ui;
  }
  PG8_WAIT_V(0);
  if (wr == 0) PG8_BAR;
  PG8_BAR;
#undef PG8_SA
#undef PG8_SB
#undef PG8_STAGE
#undef PG8_LDA
#undef PG8_LDB
#undef PG8_MMA
}

struct EpiAny {
  int mode; h16* O16; const h16* Z; float* MT; float* out; char* ws; int l, g, goff, ldo;
  __device__ __forceinline__ void operator()(const f32x4 (&acc)[2][2][4][2], int brow, int bcol, int wr, int wc, int fr, int fq) const {
    if (mode == 0) {
#pragma unroll
      for (int ai = 0; ai < 2; ++ai)
#pragma unroll
        for (int m = 0; m < 4; ++m) {
          int row = brow + ai * 128 + wr * 64 + m * 16 + fr;
#pragma unroll
          for (int bj = 0; bj < 2; ++bj) {
            int col = bcol + bj * 128 + wc * 32 + fq * 8;
            f32x4 a = acc[ai][bj][m][0], b = acc[ai][bj][m][1];
            h16x8 o = {(h16)a[0], (h16)a[1], (h16)a[2], (h16)a[3], (h16)b[0], (h16)b[1], (h16)b[2], (h16)b[3]};
            *(h16x8*)(O16 + (size_t)row * ldo + col) = o;
          }
        }
    } else if (mode <= 3) {
      const int bm = mode - 1;
#pragma unroll
      for (int ai = 0; ai < 2; ++ai)
#pragma unroll
        for (int m = 0; m < 4; ++m) {
          int row = brow + ai * 128 + wr * 64 + m * 16 + fr;
#pragma unroll
          for (int bj = 0; bj < 2; ++bj) {
            int col = bcol + bj * 128 + wc * 32 + fq * 8;
            h16x8 gt = *(const h16x8*)(Z + (size_t)row * ZOW + OC_GATE + bm * D + col);
            f32x4 a = acc[ai][bj][m][0], b = acc[ai][bj][m][1];
            float v[8];
#pragma unroll
            for (int j = 0; j < 4; ++j) { v[j] = a[j] * sigmoidf_((float)gt[j]); v[4 + j] = b[j] * sigmoidf_((float)gt[4 + j]); }
            h16* mp = O16 + (size_t)row * D + col;
            if (bm != 0) { h16x8 o = *(const h16x8*)mp;
#pragma unroll
              for (int j = 0; j < 8; ++j) v[j] += (float)o[j]; }
            h16x8 hv;
#pragma unroll
            for (int j = 0; j < 8; ++j) hv[j] = (h16)v[j];
            *(h16x8*)mp = hv;
          }
        }
    } else if (mode == 4) {
      f32x4 gt[2][2];
      {
        const int gg0 = g + brow / MG, lr0 = brow % MG;
        const float* md = modrow2(ws, l, gg0, lr0) + goff;
#pragma unroll
        for (int bj = 0; bj < 2; ++bj)
#pragma unroll
          for (int n = 0; n < 2; ++n) gt[bj][n] = *(const f32x4*)(md + bcol + bj * 128 + wc * 32 + n * 16 + fq * 4);
      }
#pragma unroll
      for (int ai = 0; ai < 2; ++ai)
#pragma unroll
        for (int m = 0; m < 4; ++m) {
          int row = brow + ai * 128 + wr * 64 + m * 16 + fr;
          const int gg = g + row / MG, lr = row % MG;
          float* xr = xrow2(out, ws, gg, lr);
#pragma unroll
          for (int bj = 0; bj < 2; ++bj)
#pragma unroll
            for (int n = 0; n < 2; ++n) {
              int col = bcol + bj * 128 + wc * 32 + n * 16 + fq * 4;
              f32x4 o = *(f32x4*)(xr + col);
              *(f32x4*)(xr + col) = o + gt[bj][n] * acc[ai][bj][m][n];
            }
        }
    } else {
      int hb = (bcol >> 8) * 128;
#pragma unroll
      for (int ai = 0; ai < 2; ++ai)
#pragma unroll
        for (int m = 0; m < 4; ++m) {
          int row = brow + ai * 128 + wr * 64 + m * 16 + fr;
          int col = hb + wc * 32 + fq * 8;
          h16x8 o;
#pragma unroll
          for (int n = 0; n < 2; ++n) {
            f32x4 a = acc[ai][0][m][n], b = acc[ai][1][m][n];
#pragma unroll
            for (int j = 0; j < 4; ++j) o[n * 4 + j] = (h16)(siluf_(a[j]) * b[j]);
          }
          *(h16x8*)(O16 + (size_t)row * DFF + col) = o;
        }
    }
  }
};

__device__ __forceinline__ void phase_mod(CP4& p, float* sm) {
  float* SC = sm;
  float* RED = sm + 17 * 1024;
  int tid = ltid();
  for (int u = blockIdx.x; u < 4 * 48; u += gridDim.x) {
    int l = u / 48, cb = (u % 48) * 128;
    __syncthreads();
    for (int e = tid; e < 17 * 1024; e += NTHREADS) {
      int i = e >> 10, k = e & 1023;
      float c = (i < 16) ? p.in[1][i * 1024 + k] : p.in[3][k];
      SC[e] = siluf_(c);
    }
    __syncthreads();
    int cj = tid & 127, kq = tid >> 7;
    const float* W = p.in[4] + (size_t)l * 1024 * 6144 + cb + cj;
    float acc[17];
#pragma unroll
    for (int i = 0; i < 17; ++i) acc[i] = 0.f;
    for (int k = kq * 256; k < kq * 256 + 256; k += 4) {
      float w0 = W[(size_t)k * 6144], w1 = W[(size_t)(k + 1) * 6144], w2 = W[(size_t)(k + 2) * 6144], w3 = W[(size_t)(k + 3) * 6144];
#pragma unroll
      for (int i = 0; i < 17; ++i) {
        float4 s = *(const float4*)(SC + i * 1024 + k);
        acc[i] += s.x * w0 + s.y * w1 + s.z * w2 + s.w * w3;
      }
    }
#pragma unroll
    for (int i = 0; i < 17; ++i) RED[(kq * 17 + i) * 128 + cj] = acc[i];
    __syncthreads();
    if (kq == 0) {
      float* MO = (float*)(p.ws + OFF_MOD);
      float b = p.in[5][l * 6144 + cb + cj];
#pragma unroll
      for (int i = 0; i < 17; ++i) {
        float v = RED[(0 * 17 + i) * 128 + cj] + RED[(1 * 17 + i) * 128 + cj] + RED[(2 * 17 + i) * 128 + cj] + RED[(3 * 17 + i) * 128 + cj];
        MO[((size_t)l * 17 + i) * 6144 + cb + cj] = v + b;
      }
    }
  }
}

__device__ __forceinline__ void phase_copyx(CP4& p) {
  size_t n1 = (size_t)NB * SEQ * D / 4, n2 = (size_t)NB * CTX * D / 4;
  const float4* s1 = (const float4*)p.in[0]; float4* d1 = (float4*)p.out;
  const float4* s2 = (const float4*)p.in[2]; float4* d2 = (float4*)(p.ws + OFF_CTXX);
  size_t stride = (size_t)gridDim.x * NTHREADS;
  for (size_t i = (size_t)blockIdx.x * NTHREADS + ltid(); i < n1; i += stride) d1[i] = s1[i];
  for (size_t i = (size_t)blockIdx.x * NTHREADS + ltid(); i < n2; i += stride) d2[i] = s2[i];
}

__device__ __forceinline__ int perm32(int rho) { const int n = rho >> 4, i = rho & 15; return 8 * (i >> 2) + 4 * n + (i & 3); }
__device__ __forceinline__ void tr_job(const float* src, int K, int Nsrc, h16* dst, int Ndst, int mode, bool perm, float* T, int b0, int nb) {
  int tk = K / 64, tn = Ndst / 64;
  int tid = ltid();
  if ((int)blockIdx.x < b0) return;
  const int lk = tid >> 4, lc = (tid & 15) * 4;
  const int sn = tid >> 3, sk = (tid & 7) * 8;
  const int ln = perm ? ((sn & 32) + perm32(sn & 31)) : sn;
  for (int u = blockIdx.x - b0; u < tk * tn; u += nb) {
    int k0 = (u % tk) * 64, n0 = (u / tk) * 64;
    int sn0;
    if (mode == 1) { int pn = n0 >> 8, j = n0 & 255; sn0 = (j < 128) ? pn * 128 + j : DFF + pn * 128 + (j - 128); }
    else if (mode == 2) sn0 = (n0 < RC) ? n0 : (n0 < ZRW ? Nsrc : n0 - (ZRW - RC));
    else sn0 = n0;
    bool valid = sn0 < Nsrc;
    f32x4 v0 = {0.f, 0.f, 0.f, 0.f}, v1 = {0.f, 0.f, 0.f, 0.f};
    if (valid) {
      v0 = *(const f32x4*)(src + (size_t)(k0 + lk) * Nsrc + sn0 + lc);
      v1 = *(const f32x4*)(src + (size_t)(k0 + lk + 32) * Nsrc + sn0 + lc);
    }
    __syncthreads();
    *(f32x4*)(T + lk * 68 + lc) = v0;
    *(f32x4*)(T + (lk + 32) * 68 + lc) = v1;
    __syncthreads();
    h16x8 o;
#pragma unroll
    for (int e = 0; e < 8; ++e) o[e] = (h16)T[(sk + e) * 68 + ln];
    *(h16x8*)(dst + (size_t)(n0 + sn) * K + k0 + sk) = o;
  }
}
__device__ __forceinline__ void phase_convert(CP4& p, int l, float* sm, int b0, int nb) {
  tr_job(p.in[8] + (size_t)l * D * PIN, D, PIN, (h16*)(p.ws + OFF_WINT), PINP, 2, true, sm, b0, nb);
  tr_job(p.in[32] + (size_t)l * D * 2 * DFF, D, 2 * DFF, (h16*)(p.ws + OFF_FFNINT), 2 * DFF, 1, true, sm, b0, nb);
  tr_job(p.in[33] + (size_t)l * DFF * D, DFF, D, (h16*)(p.ws + ((l & 1) ? OFF_FFNOUTT2 : OFF_FFNOUTT)), D, 0, false, sm, b0, nb);
  tr_job(p.in[20] + (size_t)l * D * D, D, D, (h16*)(p.ws + OFF_ROUTT), D, 0, true, sm, b0, nb);
  tr_job(p.in[31] + (size_t)l * D * D, D, D, (h16*)(p.ws + OFF_WMT), D, 0, false, sm, b0, nb);
  tr_job(p.in[25] + (size_t)l * 512 * D, 512, D, (h16*)(p.ws + OFF_COUTT), D, 0, true, sm, b0, nb);
  tr_job(p.in[30] + (size_t)l * 512 * D, 512, D, (h16*)(p.ws + OFF_SOUTT), D, 0, true, sm, b0, nb);
  tr_job(p.in[14] + (size_t)l * 128 * D, 128, D, (h16*)(p.ws + OFF_GUPT), D, 0, false, sm, b0, nb);
  if ((int)blockIdx.x < b0) return;
  const float* sw = p.in[28] + (size_t)l * 8 * 128 * 128;
  h16* dw = (h16*)(p.ws + OFF_SGUW);
  for (int i = (blockIdx.x - b0) * NTHREADS + ltid(); i < 8 * 128 * 128; i += nb * NTHREADS) dw[i] = (h16)sw[i];
}

__device__ __forceinline__ void phase_norm(CP4& p, int l, int which) {
  const float* gam = p.in[which ? 7 : 6] + l * D;
  h16* H = (h16*)(p.ws + OFF_HALL);
  int tid_ = ltid(); int lane = tid_ & 63, wv = tid_ >> 6;
  for (int r = blockIdx.x * 8 + wv; r < MALL; r += gridDim.x * 8) {
    int g = r / MG, lr = r % MG;
    const float* x = xrow(p, g, lr);
    const float* md = modrow(p, l, g, lr) + which * 3072;
    f32x4 v[4]; float ss = 0.f;
#pragma unroll
    for (int i = 0; i < 4; ++i) { v[i] = *(const f32x4*)(x + i * 256 + lane * 4); ss += v[i][0] * v[i][0] + v[i][1] * v[i][1] + v[i][2] * v[i][2] + v[i][3] * v[i][3]; }
    ss = wave_sum(ss);
    float rs = rsqrtf(ss * (1.0f / D) + 1e-6f);
#pragma unroll
    for (int i = 0; i < 4; ++i) {
      int c = i * 256 + lane * 4;
      f32x4 gm = *(const f32x4*)(gam + c), sh = *(const f32x4*)(md + c), sc = *(const f32x4*)(md + D + c);
      h16x4 o;
#pragma unroll
      for (int j = 0; j < 4; ++j) o[j] = (h16)((v[i][j] * rs * gm[j]) * (1.0f + sc[j]) + sh[j]);
      *(h16x4*)(H + (size_t)r * D + c) = o;
    }
  }
}

__device__ __forceinline__ void phase_final(CP4& p) {
  const float* gam = p.in[34];
  int tid_ = ltid(); int lane = tid_ & 63, wv = tid_ >> 6;
  for (int r = blockIdx.x * 8 + wv; r < NB * SEQ; r += gridDim.x * 8) {
    float* x = p.out + (size_t)r * D;
    f32x4 v[4]; float ss = 0.f;
#pragma unroll
    for (int i = 0; i < 4; ++i) { v[i] = *(const f32x4*)(x + i * 256 + lane * 4); ss += v[i][0] * v[i][0] + v[i][1] * v[i][1] + v[i][2] * v[i][2] + v[i][3] * v[i][3]; }
    ss = wave_sum(ss);
    float rs = rsqrtf(ss * (1.0f / D) + 1e-6f);
#pragma unroll
    for (int i = 0; i < 4; ++i) {
      int c = i * 256 + lane * 4;
      f32x4 gm = *(const f32x4*)(gam + c);
      f32x4 o = v[i] * rs * gm;
      *(f32x4*)(x + c) = o;
    }
  }
}

typedef unsigned u32x4 __attribute__((ext_vector_type(4)));
#define FMIX_LO(acc, m, u) asm("v_fma_mix_f32 %0, %1, %2, %0 op_sel:[0,0,0] op_sel_hi:[1,0,0]" : "+v"(acc) : "v"(m), "v"(u))
#define FMIX_HI(acc, m, u) asm("v_fma_mix_f32 %0, %1, %2, %0 op_sel:[1,0,0] op_sel_hi:[1,0,0]" : "+v"(acc) : "v"(m), "v"(u))
constexpr int TC = 16;
constexpr int SD_R = 0, SD_K = 4096, SD_V = 8192, SD_KKA = 12288, SD_LW = 16384, SD_LA = 18688, SD_RN = 20992, SD_RAW = 21120;
constexpr int SD_KK = SD_RAW, SD_W = SD_RAW + 4096;
constexpr int SD_AM = 32640, SD_BM = SD_AM + 2304, SD_CM = SD_BM + 2304, SD_RM = SD_CM + 2304;
constexpr int SD_BT = SD_RM + 2304, SD_CT = SD_BT + 3072, SD_VT = SD_CT + 3072;
constexpr int SD_WS = SD_VT + 3072, SD_WE = SD_WS + 256;
constexpr int SD_MCA = SD_WE + 256, SD_NBR = SD_MCA + 768, SD_NCR = SD_NBR + 768;
constexpr int SD_MBT = SD_NCR + 768;
constexpr int SD_XS = SD_MBT + 768;
constexpr int SD_SIZE = SD_XS + 4 * 1280;
static_assert(2 * SD_SIZE <= SHM_BYTES, "scan LDS layout");
constexpr int LWS = 72;
constexpr int TS = 24;
__device__ __forceinline__ void scan_chunk_geom(int c, int d, int bl, int& L, int& t0, int& rbase) {
  const int gb = (bl >> 2) * MG, b4 = bl & 3;
  if (c < CTX / TC) { L = CTX; t0 = d ? (CTX - TC * (c + 1)) : TC * c; rbase = gb + MLAT + b4 * CTX; }
  else { int cc = c - CTX / TC; L = SEQ; t0 = d ? (SEQ - TC * (cc + 1)) : TC * cc; rbase = gb + b4 * SEQ; }
}
__device__ __forceinline__ void scan_pair(CP4& p, int l, int bl, int hh, char* smc) {
  const h16* Z = (const h16*)(p.ws + OFF_ZR);
  h16* Y = (h16*)(p.ws + OFF_YH);
  const int tid = ltid(), lane = tid & 63, wv = __builtin_amdgcn_readfirstlane(tid >> 6), d = wv >> 2, wq = wv & 3, td = tid & 255;
  char* sd = smc + d * SD_SIZE;
  float* AR = (float*)(sd + SD_R); float* AK = (float*)(sd + SD_K); float* AV = (float*)(sd + SD_V);
  float* AKA = (float*)(sd + SD_KKA); float* AKK = (float*)(sd + SD_KK); float* AW = (float*)(sd + SD_W);
  float* RN = (float*)(sd + SD_RN);
  h16* LW = (h16*)(sd + SD_LW); h16* LA = (h16*)(sd + SD_LA);
  h16* AM = (h16*)(sd + SD_AM); h16* BM = (h16*)(sd + SD_BM); h16* CM = (h16*)(sd + SD_CM); h16* RM = (h16*)(sd + SD_RM);
  h16* BT = (h16*)(sd + SD_BT); h16* CT = (h16*)(sd + SD_CT); h16* VT = (h16*)(sd + SD_VT);
  float* WSC = (float*)(sd + SD_WS); float* WEC = (float*)(sd + SD_WE);
  h16* MCA = (h16*)(sd + SD_MCA); h16* NBR = (h16*)(sd + SD_NBR); h16* NCR = (h16*)(sd + SD_NCR);
  h16* MBT = (h16*)(sd + SD_MBT);
  float* XS = (float*)(sd + SD_XS + wq * 1280);
  const bool act1 = td < 240;
  const int c16 = td % 40, tk0 = td / 40, seg = c16 >> 3, cg = c16 & 7;
  const int segcol = ((seg < 3) ? seg * D + hh * 64 : (seg == 3 ? 3072 + d * 64 : 3200 + d * 64)) + cg * 8;
  const int cgA = lane & 7, tsA = lane >> 3;
  h16x8 swA0, swA1, swA2, swB0, swB1, swB2, kk8;
  {
    const int colA = ((wq < 3) ? wq * D + hh * 64 : 3072 + d * 64) + cgA * 8, colB = 3200 + d * 64 + cgA * 8;
    const float* sw = p.in[9] + (size_t)l * 3 * RC;
    const float* kkp = p.in[15] + l * D + hh * 64 + cgA * 8;
#pragma unroll
    for (int j = 0; j < 8; ++j) {
      swA0[j] = (h16)sw[colA + j]; swA1[j] = (h16)sw[RC + colA + j]; swA2[j] = (h16)sw[2 * RC + colA + j];
      swB0[j] = (h16)sw[colB + j]; swB1[j] = (h16)sw[RC + colB + j]; swB2[j] = (h16)sw[2 * RC + colB + j];
      kk8[j] = (h16)kkp[j];
    }
  }
  const int fr = lane & 15, fq = lane >> 4, jc = 16 * wq + fr;
  const float w0j = p.in[10][((size_t)l * 2 + d) * D + hh * 64 + jc];
  const float a0j = p.in[12][((size_t)l * 2 + d) * D + hh * 64 + jc];
  const float kkj = p.in[15][l * D + hh * 64 + jc];
  const float kaj = p.in[16][l * D + hh * 64 + jc];
  h16x8 Bw[2], Ba[2];
  {
    const float* wup = p.in[11] + ((size_t)l * 2 + d) * 64 * D + hh * 64 + jc;
    const float* aup = p.in[13] + ((size_t)l * 2 + d) * 64 * D + hh * 64 + jc;
#pragma unroll
    for (int ks = 0; ks < 2; ++ks)
#pragma unroll
      for (int jj = 0; jj < 8; ++jj) {
        int i = ks * 32 + fq * 8 + jj;
        Bw[ks][jj] = (h16)wup[(size_t)i * D];
        Ba[ks][jj] = (h16)aup[(size_t)i * D];
      }
  }
  f32x4 T[4];
#pragma unroll
  for (int n = 0; n < 4; ++n) T[n] = (f32x4){0.f, 0.f, 0.f, 0.f};
  const h16x8 zero8 = {0, 0, 0, 0, 0, 0, 0, 0};
  const int NCH = (CTX + SEQ) / TC;
  h16x8 pre[3];
#define RAW_LOAD(cn) do { int L_, t0_, rb_; scan_chunk_geom(cn, d, bl, L_, t0_, rb_); \
    _Pragma("unroll") for (int it = 0; it < 3; ++it) { const int row = tk0 + 6 * it; h16x8 v_ = {0, 0, 0, 0, 0, 0, 0, 0}; \
      if (act1) { int t_ = t0_ - 1 + row; \
        if (t_ >= 0 && t_ < L_) v_ = *(const h16x8*)(Z + (size_t)(rb_ + t_) * ZRW + segcol); } \
      pre[it] = v_; } } while (0)
#define RAW_STORE() do { _Pragma("unroll") for (int it = 0; it < 3; ++it) { const int row = tk0 + 6 * it; \
      if (act1) *(h16x8*)(sd + SD_RAW + row * 640 + c16 * 16) = pre[it]; } } while (0)
  __syncthreads();
  RAW_LOAD(0);
  RAW_STORE();
  __syncthreads();
  if (wv >= 4) __builtin_amdgcn_s_setprio(1);
#pragma unroll 1
  for (int c = 0; c < NCH; ++c) {
    int L, t0, rbase; scan_chunk_geom(c, d, bl, L, t0, rbase);
#pragma unroll
    for (int it = 0; it < 2; ++it) {
      const int tok = tsA + 8 * it;
      const char* rp = sd + SD_RAW + tok * 640 + (wq * 8 + cgA) * 16;
      const h16x8 ra = *(const h16x8*)rp, rb = *(const h16x8*)(rp + 640), rc = *(const h16x8*)(rp + 1280);
      float v[8];
#pragma unroll
      for (int j = 0; j < 8; ++j) v[j] = (float)ra[j] * (float)swA0[j] + (float)rb[j] * (float)swA1[j] + (float)rc[j] * (float)swA2[j];
      if (wq < 3) {
        float* dst = (wq == 0 ? AR : (wq == 1 ? AK : AV)) + tok * 64 + cgA * 8;
        *(float4*)dst = make_float4(v[0], v[1], v[2], v[3]);
        *(float4*)(dst + 4) = make_float4(v[4], v[5], v[6], v[7]);
        if (wq == 1) {
          float ss = 0.f;
#pragma unroll
          for (int j = 0; j < 8; ++j) { float t_ = v[j] * (float)kk8[j]; ss += t_ * t_; }
          ss += __shfl_xor(ss, 1, 64); ss += __shfl_xor(ss, 2, 64); ss += __shfl_xor(ss, 4, 64);
          if (cgA == 0) RN[tok] = rsqrtf(fmaxf(ss, 1e-24f));
        }
      } else {
        h16x8 o;
#pragma unroll
        for (int j = 0; j < 8; ++j) o[j] = (h16)tanhf_(v[j]);
        *(h16x8*)(LW + tok * LWS + cgA * 8) = o;
      }
    }
    if (lane < 32) {
      const int tok = tsA + 4 * wq;
      const char* rp = sd + SD_RAW + tok * 640 + (32 + cgA) * 16;
      const h16x8 ra = *(const h16x8*)rp, rb = *(const h16x8*)(rp + 640), rc = *(const h16x8*)(rp + 1280);
      h16x8 o;
#pragma unroll
      for (int j = 0; j < 8; ++j) o[j] = (h16)((float)ra[j] * (float)swB0[j] + (float)rb[j] * (float)swB1[j] + (float)rc[j] * (float)swB2[j]);
      *(h16x8*)(LA + tok * LWS + cgA * 8) = o;
    }
    __syncthreads();
    {
      f32x4 cw = {0.f, 0.f, 0.f, 0.f}, ca = {0.f, 0.f, 0.f, 0.f};
#pragma unroll
      for (int ks = 0; ks < 2; ++ks) {
        h16x8 alw = *(const h16x8*)(LW + fr * LWS + ks * 32 + fq * 8);
        h16x8 ala = *(const h16x8*)(LA + fr * LWS + ks * 32 + fq * 8);
        cw = __builtin_amdgcn_mfma_f32_16x16x32_f16(alw, Bw[ks], cw, 0, 0, 0);
        ca = __builtin_amdgcn_mfma_f32_16x16x32_f16(ala, Ba[ks], ca, 0, 0, 0);
      }
#pragma unroll
      for (int rg = 0; rg < 4; ++rg) {
        int tok = fq * 4 + rg;
        float dec = __expf(-0.6065306597126334f * sigmoidf_(cw[rg] + w0j));
        float a = sigmoidf_(ca[rg] + a0j);
        float k = AK[tok * 64 + jc];
        float kk = k * kkj * RN[tok];
        AKK[tok * 64 + jc] = kk;
        AKA[tok * 64 + jc] = kk * a;
        AW[tok * 64 + jc] = dec;
        AK[tok * 64 + jc] = k * (1.0f + (a - 1.0f) * kaj);
      }
    }
    if (c + 1 < NCH) RAW_LOAD(c + 1);
    __syncthreads();
    {
      float wref = 1.0f;
#pragma unroll
      for (int s = 0; s < 8; ++s) wref *= AW[(d ? (TC - 1 - s) : s) * 64 + lane];
      float qprev = __builtin_amdgcn_rcpf(wref);
      if (wq == 0) {
#pragma unroll
        for (int s = 0; s < TC; ++s) {
          const int tok = d ? (TC - 1 - s) : s;
          AM[s * LWS + lane] = (h16)(qprev * AKK[tok * 64 + lane]);
          qprev *= AW[tok * 64 + lane];
        }
      } else if (wq == 1) {
#pragma unroll
        for (int s = 0; s < TC; ++s) {
          const int tok = d ? (TC - 1 - s) : s;
          qprev *= AW[tok * 64 + lane];
          const h16 hb = (h16)(AKA[tok * 64 + lane] * __builtin_amdgcn_rcpf(qprev));
          BM[s * LWS + lane] = hb; BT[lane * TS + s] = -hb;
        }
      } else if (wq == 2) {
#pragma unroll
        for (int s = 0; s < TC; ++s) {
          const int tok = d ? (TC - 1 - s) : s;
          qprev *= AW[tok * 64 + lane];
          const h16 hc = (h16)(AK[tok * 64 + lane] * __builtin_amdgcn_rcpf(qprev));
          CM[s * LWS + lane] = hc; CT[lane * TS + s] = hc;
        }
      } else {
        WSC[lane] = wref;
#pragma unroll
        for (int s = 0; s < TC; ++s) {
          const int tok = d ? (TC - 1 - s) : s;
          qprev *= AW[tok * 64 + lane];
          RM[s * LWS + lane] = (h16)(qprev * AR[tok * 64 + lane]);
          VT[lane * TS + s] = (h16)AV[tok * 64 + lane];
        }
        WEC[lane] = qprev;
      }
    }
    __syncthreads();
    if (c + 1 < NCH) RAW_STORE();
    f32x4 P1 = {0.f, 0.f, 0.f, 0.f}, P2 = {0.f, 0.f, 0.f, 0.f};
    {
#pragma unroll
      for (int tt = 0; tt < 4; ++tt) { f32x4 sc = *(const f32x4*)(WSC + tt * 16 + fq * 4); T[tt] = T[tt] * sc; }
#pragma unroll
      for (int ks = 0; ks < 2; ++ks) {
        h16x8 tb;
#pragma unroll
        for (int e = 0; e < 4; ++e) { tb[e] = (h16)T[2 * ks][e]; tb[4 + e] = (h16)T[2 * ks + 1][e]; }
        const h16* ap = AM + fr * LWS + ks * 32 + fq * 4;
        const h16* rp = RM + fr * LWS + ks * 32 + fq * 4;
        h16x4 a0 = *(const h16x4*)ap, a1 = *(const h16x4*)(ap + 16), r0 = *(const h16x4*)rp, r1 = *(const h16x4*)(rp + 16);
        h16x8 af = {a0[0], a0[1], a0[2], a0[3], a1[0], a1[1], a1[2], a1[3]};
        h16x8 rf = {r0[0], r0[1], r0[2], r0[3], r1[0], r1[1], r1[2], r1[3]};
        P1 = __builtin_amdgcn_mfma_f32_16x16x32_f16(af, tb, P1, 0, 0, 0);
        P2 = __builtin_amdgcn_mfma_f32_16x16x32_f16(rf, tb, P2, 0, 0, 0);
      }
      const h16* lhs = (wq & 1) ? CM : BM;
      const h16* rhs = (wq & 2) ? RM : AM;
      f32x4 m = {0.f, 0.f, 0.f, 0.f};
#pragma unroll
      for (int ks = 0; ks < 2; ++ks) {
        h16x8 lf = *(const h16x8*)(lhs + fr * LWS + ks * 32 + fq * 8);
        h16x8 gf = *(const h16x8*)(rhs + fr * LWS + ks * 32 + fq * 8);
        m = __builtin_amdgcn_mfma_f32_16x16x32_f16(lf, gf, m, 0, 0, 0);
      }
#pragma unroll
      for (int r = 0; r < 4; ++r) { const int j = 4 * fq + r; const bool keep = (wq & 2) ? (j <= fr) : (j < fr); m[r] = keep ? m[r] : 0.f; }
      {
        if (wq == 0 || wq == 2) m = -m;
        h16x4 mh = {(h16)m[0], (h16)m[1], (h16)m[2], (h16)m[3]};
        *(h16x4*)((wq == 0 ? MBT : (wq == 1 ? MCA : (wq == 2 ? NBR : NCR))) + fr * TS + fq * 4) = mh;
      }
    }
    __syncthreads();
    {
      const bool lo2 = fq < 2;
      const h16x8 vf = lo2 ? *(const h16x8*)(VT + (wq * 16 + fr) * TS + fq * 8) : zero8;
      const h16x8 mcf = lo2 ? *(const h16x8*)(MCA + fr * TS + fq * 8) : zero8;
      f32x4 Xv = __builtin_amdgcn_mfma_f32_16x16x32_f16(mcf, vf, P1, 0, 0, 0);
      f32x4 ufin = {0.f, 0.f, 0.f, 0.f};
      {
        const h16x4 d1 = *(const h16x4*)(MBT + (4 * fq + 1) * TS + 4 * fq);
        const h16x4 d2 = *(const h16x4*)(MBT + (4 * fq + 2) * TS + 4 * fq);
        const h16x4 d3 = *(const h16x4*)(MBT + (4 * fq + 3) * TS + 4 * fq);
        const h16x4 ma = *(const h16x4*)(MBT + fr * TS + 4 * fq);
        const h16x8 maf = {ma[0], ma[1], ma[2], ma[3], 0, 0, 0, 0};
#pragma unroll
        for (int blk = 0; blk < 4; ++blk) {
          const float u0 = Xv[0];
          const float u1 = Xv[1] + (float)d1[0] * u0;
          const float u2 = Xv[2] + (float)d2[0] * u0 + (float)d2[1] * u1;
          const float u3 = Xv[3] + (float)d3[0] * u0 + (float)d3[1] * u1 + (float)d3[2] * u2;
          const bool mine = (fq == blk);
          ufin[0] = mine ? u0 : ufin[0]; ufin[1] = mine ? u1 : ufin[1]; ufin[2] = mine ? u2 : ufin[2]; ufin[3] = mine ? u3 : ufin[3];
          if (blk < 3) {
            const h16x8 ub = {(h16)u0, (h16)u1, (h16)u2, (h16)u3, 0, 0, 0, 0};
            Xv = __builtin_amdgcn_mfma_f32_16x16x32_f16(maf, mine ? ub : zero8, Xv, 0, 0, 0);
          }
        }
      }
      const h16x8 uf = {(h16)ufin[0], (h16)ufin[1], (h16)ufin[2], (h16)ufin[3], 0, 0, 0, 0};
      const h16x4 nb4 = *(const h16x4*)(NBR + fr * TS + 4 * fq);
      const h16x8 nbf = {nb4[0], nb4[1], nb4[2], nb4[3], 0, 0, 0, 0};
      const h16x8 ncf = lo2 ? *(const h16x8*)(NCR + fr * TS + fq * 8) : zero8;
      f32x4 Yv = __builtin_amdgcn_mfma_f32_16x16x32_f16(nbf, uf, P2, 0, 0, 0);
      Yv = __builtin_amdgcn_mfma_f32_16x16x32_f16(ncf, vf, Yv, 0, 0, 0);
      {
        h16* yb = Y + ((size_t)d * MALL + rbase + t0) * D + hh * 64 + wq * 16 + fr;
#pragma unroll
        for (int r = 0; r < 4; ++r) { const int s = 4 * fq + r; const int tok = d ? (TC - 1 - s) : s; yb[(size_t)tok * D] = (h16)(Yv[r] * YSC); }
      }
#pragma unroll
      for (int tt = 0; tt < 4; ++tt) {
        const h16x4 bt4 = *(const h16x4*)(BT + (tt * 16 + fr) * TS + fq * 4);
        const h16x8 btf = {bt4[0], bt4[1], bt4[2], bt4[3], 0, 0, 0, 0};
        const h16x8 ctf = lo2 ? *(const h16x8*)(CT + (tt * 16 + fr) * TS + fq * 8) : zero8;
        T[tt] = __builtin_amdgcn_mfma_f32_16x16x32_f16(btf, uf, T[tt], 0, 0, 0);
        T[tt] = __builtin_amdgcn_mfma_f32_16x16x32_f16(ctf, vf, T[tt], 0, 0, 0);
        f32x4 sc = *(const f32x4*)(WEC + tt * 16 + fq * 4);
        T[tt] = T[tt] * sc;
      }
    }
  }
  __builtin_amdgcn_s_setprio(0);
#undef RAW_LOAD
#undef RAW_STORE
}

__device__ __forceinline__ void conv_unit(CP4& p, int l, int g, int rowbase, int stride, int L, int p0, char* smc) {
  const h16* Z = (const h16*)(p.ws + OFF_ZO + (size_t)(g & 1) * ZO_BYTES);
  h16* BP = (h16*)(p.ws + OFF_BPRE);
  h16* U = (h16*)smc;
  float* Yc = (float*)(smc + 62 * 512 * 2);
  int tid = ltid(), lane = tid & 63, wv = tid >> 6;
  __syncthreads();
#pragma unroll
  for (int i8 = 0; i8 < 8; ++i8) {
    const int pp = wv + 8 * i8;
    if (pp >= 62) break;
    int pos = p0 - 15 + pp;
    h16x8 o;
    if (pos >= 0 && pos < L) {
      size_t r = (size_t)(rowbase + pos * stride);
      h16x8 a = *(const h16x8*)(Z + r * ZOW + OC_CONV + lane * 8);
      h16x8 b = *(const h16x8*)(Z + r * ZOW + OC_CONV + 512 + lane * 8);
#pragma unroll
      for (int j = 0; j < 8; ++j) o[j] = (h16)((float)a[j] * sigmoidf_((float)b[j]));
    } else {
#pragma unroll
      for (int j = 0; j < 8; ++j) o[j] = (h16)0.f;
    }
    *(h16x8*)(U + pp * 512 + lane * 8) = o;
  }
  __syncthreads();
  {
    const float* dw = p.in[21] + (size_t)l * 31 * 512 + tid;
    float w[31];
#pragma unroll
    for (int j = 0; j < 31; ++j) w[j] = dw[j * 512];
    float bias = p.in[22][l * 512 + tid];
    float uin[62];
#pragma unroll
    for (int pp = 0; pp < 62; ++pp) uin[pp] = (float)U[pp * 512 + tid];
#pragma unroll
    for (int pp = 0; pp < 32; ++pp) {
      float acc = bias;
#pragma unroll
      for (int j = 0; j < 31; ++j) acc += uin[pp + j] * w[j];
      Yc[pp * 512 + tid] = acc;
    }
  }
  __syncthreads();
  const float* lg = p.in[23] + l * 512 + lane * 8;
  const float* lb = p.in[24] + l * 512 + lane * 8;
  for (int pp = wv; pp < 32; pp += 8) {
    float v[8]; float s = 0.f;
#pragma unroll
    for (int j = 0; j < 8; ++j) { v[j] = Yc[pp * 512 + lane * 8 + j]; s += v[j]; }
    float mean = wave_sum(s) * (1.0f / 512);
    float s2 = 0.f;
#pragma unroll
    for (int j = 0; j < 8; ++j) { v[j] -= mean; s2 += v[j] * v[j]; }
    float rstd = rsqrtf(wave_sum(s2) * (1.0f / 512) + 1e-5f);
    h16x8 o;
#pragma unroll
    for (int j = 0; j < 8; ++j) { float t = v[j] * rstd * lg[j] + lb[j]; o[j] = (h16)siluf_(t); }
    size_t r = (size_t)(rowbase + (p0 + pp) * stride);
    *(h16x8*)(BP + r * 512 + lane * 8) = o;
  }
}

__device__ __forceinline__ void sgu_unit(CP4& p, int l, int g, int row0, char* smc) {
  const h16* Z = (const h16*)(p.ws + OFF_ZO + (size_t)(g & 1) * ZO_BYTES);
  h16* CP = (h16*)(p.ws + OFF_CPRE);
  const h16* SW = (const h16*)(p.ws + OFF_SGUW);
  float* MEAN = (float*)smc;
  float* RSTD = MEAN + 128;
  h16* VT = (h16*)(smc + 1024);
  const int tid = ltid(), lane = tid & 63, wv = tid >> 6, fr = lane & 15, fq = lane >> 4;
  __syncthreads();
#pragma unroll 1
  for (int t4 = 0; t4 < 4; ++t4) {
    float s[4], s2[4];
#pragma unroll
    for (int k = 0; k < 4; ++k) {
      int tk = wv * 16 + t4 * 4 + k;
      h16x8 a = *(const h16x8*)(Z + (size_t)(row0 + tk) * ZOW + OC_SGU + 512 + lane * 8);
      s[k] = 0.f; s2[k] = 0.f;
#pragma unroll
      for (int j = 0; j < 8; ++j) { float v = geluf_((float)a[j]); s[k] += v; s2[k] += v * v; }
    }
#pragma unroll
    for (int m = 32; m >= 1; m >>= 1)
#pragma unroll
      for (int k = 0; k < 4; ++k) { s[k] += __shfl_xor(s[k], m, 64); s2[k] += __shfl_xor(s2[k], m, 64); }
    if (lane == 0) {
#pragma unroll
      for (int k = 0; k < 4; ++k) {
        float mean = s[k] * (1.0f / 512);
        float var = fmaxf(s2[k] * (1.0f / 512) - mean * mean, 0.f);
        MEAN[wv * 16 + t4 * 4 + k] = mean; RSTD[wv * 16 + t4 * 4 + k] = rsqrtf(var + 1e-5f);
      }
    }
  }
  __syncthreads();
  const float* lg = p.in[26] + l * 512;
  const float* lb = p.in[27] + l * 512;
  const float* bs = p.in[29] + (size_t)l * 8 * 128;
#pragma unroll 1
  for (int g8 = 0; g8 < 8; ++g8) {
    {
      const int qk = tid & 127, d0 = (tid >> 7) * 16;
      const float mean = MEAN[qk], rstd = RSTD[qk];
      const h16* src = Z + (size_t)(row0 + qk) * ZOW + OC_SGU + 512 + g8 * 64 + d0;
      h16x8 a0 = *(const h16x8*)src, a1 = *(const h16x8*)(src + 8);
#pragma unroll
      for (int j = 0; j < 8; ++j) {
        int c0 = g8 * 64 + d0 + j, c1 = c0 + 8;
        float v0 = (geluf_((float)a0[j]) - mean) * rstd * lg[c0] + lb[c0];
        float v1 = (geluf_((float)a1[j]) - mean) * rstd * lg[c1] + lb[c1];
        VT[(d0 + j) * 136 + qk] = (h16)v0;
        VT[(d0 + j + 8) * 136 + qk] = (h16)v1;
      }
    }
    __syncthreads();
    f32x4 acc[4];
#pragma unroll
    for (int dt = 0; dt < 4; ++dt) acc[dt] = (f32x4){0.f, 0.f, 0.f, 0.f};
#pragma unroll
    for (int ks = 0; ks < 4; ++ks) {
      h16x8 af = *(const h16x8*)(SW + ((size_t)g8 * 128 + wv * 16 + fr) * 128 + ks * 32 + fq * 8);
#pragma unroll
      for (int dt = 0; dt < 4; ++dt) {
        h16x8 bf = *(const h16x8*)(VT + (dt * 16 + fr) * 136 + ks * 32 + fq * 8);
        acc[dt] = __builtin_amdgcn_mfma_f32_16x16x32_f16(bf, af, acc[dt], 0, 0, 0);
      }
    }
    {
      const int pr = wv * 16 + fr;
      const float bias = bs[g8 * 128 + pr];
      const h16* up = Z + (size_t)(row0 + pr) * ZOW + OC_SGU + g8 * 64 + fq * 4;
      h16* cp = CP + (size_t)(row0 + pr) * 512 + g8 * 64 + fq * 4;
#pragma unroll
      for (int dt = 0; dt < 4; ++dt) {
        h16x4 u4 = *(const h16x4*)(up + dt * 16);
        h16x4 o;
#pragma unroll
        for (int j = 0; j < 4; ++j) o[j] = (h16)(geluf_((float)u4[j]) * (acc[dt][j] + bias));
        *(h16x4*)(cp + dt * 16) = o;
      }
    }
    __syncthreads();
  }
}

__device__ __forceinline__ void phase_scan(CP4& p, int l, char* smc) {
  for (int pr = blockIdx.x; pr < NB * 16; pr += gridDim.x) scan_pair(p, l, pr >> 4, pr & 15, smc);
}
__device__ __forceinline__ void phase_convsgu(CP4& p, int l, int g, char* smc) {
  const bool last = (l == DEPTH - 1);
  int nb = gridDim.x, bi = blockIdx.x;
  int nconv_lat = GB * 64, nconv = nconv_lat + (last ? 0 : GB * 8);
  for (int u = (bi + nb - 144 % nb) % nb; u < nconv; u += nb) {
    int rowbase, stride, Lc, p0;
    if (u < nconv_lat) {
      int bl = u >> 6, w = u & 63;
      if ((l & 1) == 0) { rowbase = bl * SEQ + (w >> 1) * 64; stride = 1; Lc = 64; p0 = (w & 1) * 32; }
      else { rowbase = bl * SEQ + w; stride = 64; Lc = 32; p0 = 0; }
    } else {
      int uu = u - nconv_lat, bl = uu >> 3, sg = uu & 7;
      rowbase = MLAT + bl * CTX; stride = 1; Lc = CTX; p0 = sg * 32;
    }
    conv_unit(p, l, g, rowbase, stride, Lc, p0, smc);
  }
  int nsgu = last ? MLAT / 128 : MG / 128;
  for (int u = nb - 1 - bi; u < nsgu; u += nb) sgu_unit(p, l, g, u * 128, smc);
}

__device__ __forceinline__ void phase_postscan(CP4& p, int l, char* smc) {
  const bool last = (l == DEPTH - 1);
  const h16* Z = (const h16*)(p.ws + OFF_ZR);
  const h16* Y = (const h16*)(p.ws + OFF_YH);
  const h16* GT = (const h16*)(p.ws + OFF_GUPT);
  h16* AP = (h16*)(p.ws + OFF_APRE);
  const float* sw = p.in[9] + (size_t)l * 3 * RC;
  float* SWR = (float*)smc;
  float* GNC = SWR + 9 * 1024;
  h16* SG = (h16*)(GNC + 3 * 1024);
  h16* G = SG + 32 * 136;
  const int tid = ltid(), lane = tid & 63, wv = tid >> 6, fr = lane & 15, fq = lane >> 4;
  __syncthreads();
  for (int e = tid; e < 9 * 1024; e += NTHREADS) { int st = e >> 10, col = e & 1023, sg = st / 3, tap = st % 3; SWR[e] = sw[tap * RC + sg * D + col]; }
  for (int e = tid; e < 1024; e += NTHREADS) { GNC[e] = p.in[18][l * D + e]; GNC[1024 + e] = p.in[19][l * D + e]; GNC[2048 + e] = p.in[17][l * D + e]; }
  float sg0[8], sg1[8], sg2[8];
  {
    int kc = (tid & 15) * 8;
#pragma unroll
    for (int j = 0; j < 8; ++j) { sg0[j] = sw[3328 + kc + j]; sg1[j] = sw[RC + 3328 + kc + j]; sg2[j] = sw[2 * RC + 3328 + kc + j]; }
  }
  const h16x8 zero8 = {0, 0, 0, 0, 0, 0, 0, 0};
  const int ntiles = MALL / 32;
  for (int u = blockIdx.x; u < ntiles; u += gridDim.x) {
    const int row0 = u * 32;
    if (last && (row0 % MG) >= MLAT) continue;
    __syncthreads();
    {
      int tok = tid >> 4, kc = (tid & 15) * 8;
      int r = row0 + tok, t, L; seqposG(r, t, L);
      const h16* zp = Z + (size_t)r * ZRW + 3328 + kc;
      h16x8 b = *(const h16x8*)zp;
      h16x8 a = (t > 0) ? *(const h16x8*)(zp - ZRW) : zero8;
      h16x8 c = (t < L - 1) ? *(const h16x8*)(zp + ZRW) : zero8;
      h16x8 o;
#pragma unroll
      for (int j = 0; j < 8; ++j) o[j] = (h16)sigmoidf_((float)a[j] * sg0[j] + (float)b[j] * sg1[j] + (float)c[j] * sg2[j]);
      *(h16x8*)(SG + tok * 136 + kc) = o;
    }
    __syncthreads();
    {
      h16x8 af[2][4];
#pragma unroll
      for (int m = 0; m < 2; ++m)
#pragma unroll
        for (int ks = 0; ks < 4; ++ks) af[m][ks] = *(const h16x8*)(SG + (m * 16 + fr) * 136 + ks * 32 + fq * 8);
#pragma unroll
      for (int nt = 0; nt < 8; ++nt) {
        f32x4 acc0 = {0.f, 0.f, 0.f, 0.f}, acc1 = {0.f, 0.f, 0.f, 0.f};
        const h16* bp = GT + (size_t)(wv * 128 + nt * 16 + fr) * 128 + fq * 8;
#pragma unroll
        for (int ks = 0; ks < 4; ++ks) {
          h16x8 bf = *(const h16x8*)(bp + ks * 32);
          acc0 = __builtin_amdgcn_mfma_f32_16x16x32_f16(af[0][ks], bf, acc0, 0, 0, 0);
          acc1 = __builtin_amdgcn_mfma_f32_16x16x32_f16(af[1][ks], bf, acc1, 0, 0, 0);
        }
#pragma unroll
        for (int rg = 0; rg < 4; ++rg) {
          G[(fq * 4 + rg) * 1024 + wv * 128 + nt * 16 + fr] = (h16)acc0[rg];
          G[(16 + fq * 4 + rg) * 1024 + wv * 128 + nt * 16 + fr] = (h16)acc1[rg];
        }
      }
    }
    __syncthreads();
#pragma unroll 1
    for (int it = 0; it < 8; ++it) {
      const int tok = (tid >> 7) + 4 * it, col = (tid & 127) * 8;
      const int r = row0 + tok; int t, L; seqposG(r, t, L);
      const bool hp = t > 0, hn = t < L - 1;
      const h16* zp = Z + (size_t)r * ZRW + col;
      h16x8 yf = *(const h16x8*)(Y + (size_t)r * D + col), yb = *(const h16x8*)(Y + ((size_t)MALL + r) * D + col);
      h16x8 z[3][3];
#pragma unroll
      for (int sg = 0; sg < 3; ++sg) {
        z[sg][1] = *(const h16x8*)(zp + sg * D);
        z[sg][0] = hp ? *(const h16x8*)(zp + sg * D - ZRW) : zero8;
        z[sg][2] = hn ? *(const h16x8*)(zp + sg * D + ZRW) : zero8;
      }
      float y[8], s = 0.f;
#pragma unroll
      for (int j = 0; j < 8; ++j) { y[j] = ((float)yf[j] + (float)yb[j]) * YUN; s += y[j]; }
      s += __shfl_xor(s, 1, 64); s += __shfl_xor(s, 2, 64); s += __shfl_xor(s, 4, 64);
      const float mean = s * (1.0f / 64);
      float s2 = 0.f;
#pragma unroll
      for (int j = 0; j < 8; ++j) { y[j] -= mean; s2 += y[j] * y[j]; }
      s2 += __shfl_xor(s2, 1, 64); s2 += __shfl_xor(s2, 2, 64); s2 += __shfl_xor(s2, 4, 64);
      const float rstd = rsqrtf(s2 * (1.0f / 64) + 64e-5f);
      float vv[8], bs = 0.f;
#pragma unroll
      for (int j = 0; j < 8; ++j) {
        float rr = (float)z[0][0][j] * SWR[0 * 1024 + col + j] + (float)z[0][1][j] * SWR[1 * 1024 + col + j] + (float)z[0][2][j] * SWR[2 * 1024 + col + j];
        float kk = (float)z[1][0][j] * SWR[3 * 1024 + col + j] + (float)z[1][1][j] * SWR[4 * 1024 + col + j] + (float)z[1][2][j] * SWR[5 * 1024 + col + j];
        vv[j] = (float)z[2][0][j] * SWR[6 * 1024 + col + j] + (float)z[2][1][j] * SWR[7 * 1024 + col + j] + (float)z[2][2][j] * SWR[8 * 1024 + col + j];
        bs += rr * kk * GNC[2048 + col + j];
      }
      bs += __shfl_xor(bs, 1, 64); bs += __shfl_xor(bs, 2, 64); bs += __shfl_xor(bs, 4, 64);
      const h16x8 g8 = *(const h16x8*)(G + tok * 1024 + col);
      h16x8 o;
#pragma unroll
      for (int j = 0; j < 8; ++j) {
        float yn = y[j] * rstd * GNC[col + j] + GNC[1024 + col + j];
        o[j] = (h16)((yn + bs * vv[j]) * (float)g8[j]);
      }
      *(h16x8*)(AP + (size_t)r * D + col) = o;
    }
  }
}

constexpr int NLS = 5, NST = 6, NLE = 3;
constexpr int NPL = NLS + NG * NST + NLE;
constexpr int NPHASE = 2 + DEPTH * NPL + 1;

__device__ __forceinline__ void decode_phase(int ph, int& kind, int& l, int& g, int& st) {
  l = g = st = 0;
  if (ph == 0) { kind = 0; return; }
  if (ph == 1) { kind = 1; return; }
  if (ph == NPHASE - 1) { kind = 2; return; }
  int q = ph - 2; l = q / NPL; int s = q % NPL;
  if (s < NLS) { kind = 3; st = s; return; }
  s -= NLS;
  if (s < NG * NST) { kind = 4; g = s / NST; st = s % NST; return; }
  kind = 3; st = NLS + (s - NG * NST);
}
__device__ __forceinline__ bool step_needs_sync(int kind, int l, int g, int st) {
  if (kind == 3 && st == 0 && l > 0) return false;
  if (kind != 4) return true;
  if (st == 0) return g == 0;
  return st == 2 || st == 4 || st == 5;
}

__device__ __forceinline__ void run_nongemm(CP4& p, int kind, int l, int g, int st, char* smc) {
  if (kind == 0) phase_mod(p, (float*)smc);
  else if (kind == 1) phase_copyx(p);
  else if (kind == 2) phase_final(p);
  else if (kind == 3) {
    if (st == 1) phase_norm(p, l, 0);
    else if (st == 3) phase_scan(p, l, smc);
    else if (st == 4) phase_postscan(p, l, smc);
    else if (st == 5) phase_norm(p, l, 1);
  } else {
    if (st == 1) phase_convsgu(p, l, g, smc);
  }
}

__device__ __forceinline__ int opq(int x) { asm volatile("" : "+v"(x)); return __builtin_amdgcn_readfirstlane(x); }
__device__ __forceinline__ size_t opq64(size_t x) { int lo = opq((int)(unsigned)x), hi = opq((int)(unsigned)(x >> 32)); return ((size_t)(unsigned)hi << 32) | (unsigned)lo; }
struct GemmDesc { size_t offA, offB, offO, offZ; int K, nM, nN, mode, goff, ldo, ubeg, uend, brot, nblk, valid; };
__device__ __forceinline__ GemmDesc gemm_desc(int kind, int l, int g, int st, int j) {
  const bool last = (l == DEPTH - 1);
  const int nMr = (last ? MLAT : MG) / BM;
  const int grid = gridDim.x;
  GemmDesc d{};
  d.brot = 0; d.nblk = grid; d.valid = 0; d.offZ = OFF_ZO + (size_t)(g & 1) * ZO_BYTES;
  if (kind == 3) {
    if (j != 0) return d;
    d.valid = 1;
    if (st == 2) { d.offA = OFF_HALL; d.offB = OFF_WINT; d.offO = OFF_ZR; d.K = D; d.nM = MALL / BM; d.nN = ZRW / BM; d.mode = 0; d.ldo = ZRW; }
    else if (st == 6) { d.offA = OFF_HALL; d.offB = OFF_FFNINT; d.offO = OFF_HID; d.K = D; d.nM = MALL / BM; d.nN = 2 * DFF / BM; d.mode = 5; d.ldo = DFF; }
    else if (st == 7) { d.offA = OFF_HID; d.offB = (l & 1) ? OFF_FFNOUTT2 : OFF_FFNOUTT; d.offO = OFF_HID; d.K = DFF; d.nM = MALL / BM; d.nN = D / BM; d.mode = 4; d.goff = 5120; d.ldo = D; }
    else d.valid = 0;
    d.ubeg = 0; d.uend = d.nM * d.nN;
    return d;
  }
  if (kind != 4) return d;
  const bool shadow = (j > 0);
  const int gz = shadow ? g + 1 : g;
  if ((st == 0 && j == 0 && g == 0) || (shadow && gz < NG && ((st == 4 && j == 1) || (st == 5)))) {
    d.valid = 1;
    d.offA = OFF_HALL + (size_t)gz * MG * D * 2; d.offB = OFF_WINT + (size_t)ZRW * D * 2; d.offO = OFF_ZO + (size_t)(gz & 1) * ZO_BYTES;
    d.K = D; d.nM = nMr; d.nN = ZOW / BM; d.mode = 0; d.ldo = ZOW;
    const int tot = d.nM * d.nN;
    d.ubeg = 0; d.uend = tot;
    if (shadow) {
      const int nsh = grid > 144 ? grid - 144 : 0;
      const int nA = min(3 * nsh, tot), nB1 = min(nA + 2 * nsh, tot);
      if (st == 4) { d.ubeg = 0; d.uend = nA; d.brot = 144; d.nblk = nsh; }
      else if (j == 1) { d.ubeg = nA; d.uend = nB1; d.brot = 144; d.nblk = nsh; }
      else { d.ubeg = nB1; d.uend = tot; d.brot = 0; d.nblk = grid; }
      if (d.ubeg >= d.uend) d.valid = 0;
    }
    return d;
  }
  if (j != 0) return d;
  d.valid = 1; d.nM = nMr; d.nN = D / BM; d.ldo = D; d.offO = OFF_M16;
  if (st == 2) { d.offA = OFF_APRE + (size_t)g * MG * D * 2; d.offB = OFF_ROUTT; d.K = 1024; d.mode = 1; }
  else if (st == 3) { d.offA = OFF_BPRE; d.offB = OFF_COUTT; d.K = 512; d.mode = 2; }
  else if (st == 4) { d.offA = OFF_CPRE; d.offB = OFF_SOUTT; d.K = 512; d.mode = 3; }
  else if (st == 5) { d.offA = OFF_M16; d.offB = OFF_WMT; d.K = D; d.mode = 4; d.goff = 2048; }
  else d.valid = 0;
  d.ubeg = 0; d.uend = d.nM * d.nN;
  return d;
}

__global__ void __launch_bounds__(NTHREADS) mk(P p, int ph0, int ph1, int coop) {
  extern __shared__ __attribute__((aligned(16))) char smc[];
  cg::grid_group grid = cg::this_grid();
  CP4* pp = (CP4*)__builtin_amdgcn_kernarg_segment_ptr();
  unsigned nbar = 0;
#pragma nounroll
  for (int ph = ph0; ph < ph1; ++ph) {
    CP4* q = pp;
    asm volatile("" : "+s"(q));
    int kind, l, g, st; decode_phase(ph, kind, l, g, st);
    run_nongemm(*q, kind, l, g, st, smc);
#pragma nounroll
    for (int j = 0; j < 3; ++j) {
      GemmDesc d = gemm_desc(kind, l, g, st, j);
      d.offA = opq64(d.offA); d.offB = opq64(d.offB); d.offO = opq64(d.offO); d.offZ = opq64(d.offZ);
      d.K = opq(d.K); d.nM = opq(d.nM); d.nN = opq(d.nN); d.mode = opq(d.mode); d.goff = opq(d.goff); d.ldo = opq(d.ldo);
      d.ubeg = opq(d.ubeg); d.uend = opq(d.uend); d.brot = opq(d.brot); d.nblk = opq(d.nblk); d.valid = opq(d.valid);
      if (!d.valid) continue;
      char* ws = q->ws;
      EpiAny e{d.mode, (h16*)(ws + d.offO), (const h16*)(ws + d.offZ), nullptr, q->out, ws, l, (kind == 3 ? 0 : g), d.goff, d.ldo};
      gemm_phase((LAS unsigned char*)smc, (const h16*)(ws + d.offA), (const h16*)(ws + d.offB), d.K, 0, d.nM, d.nN, d.ubeg, d.uend, d.brot, d.nblk, e);
    }
    {
      int cl = -1, cb0 = 0;
      if (kind == 3 && st == 0 && l == 0) cl = 0;
      if (kind == 3 && st == 7 && l + 1 < DEPTH) { cl = l + 1; cb0 = (gridDim.x > 128) ? 64 : 0; }
      if (cl >= 0) phase_convert(*q, cl, (float*)smc, cb0, (int)gridDim.x - cb0);
    }
    if (coop && ph + 1 < ph1 && step_needs_sync(kind, l, g, st) && ph >= 2) {
      if (ph == 2) grid.sync();
      else { ++nbar; grid_bar((unsigned*)(q->ws + OFF_BAR), nbar * gridDim.x); }
    }
  }
}

extern "C" void kernel_launch(void* const* d_in, const int* in_sizes, int n_in, void* d_out, int out_size, void* d_ws, size_t ws_size,
                              hipStream_t stream) {
  if (ws_size < WS_TOTAL) return;
  P p{};
  for (int i = 0; i < 35; ++i) p.in[i] = (const float*)d_in[i];
  p.out = (float*)d_out;
  p.ws = (char*)d_ws;
  static bool attr = false;
  if (!attr) { (void)hipFuncSetAttribute((const void*)mk, hipFuncAttributeMaxDynamicSharedMemorySize, SHM_BYTES); attr = true; }
#if COOP
  static int grid_blocks = 0;
  if (!grid_blocks) {
    int dev = 0, cus = 0, per_cu = 0;
    (void)hipGetDevice(&dev);
    (void)hipDeviceGetAttribute(&cus, hipDeviceAttributeMultiprocessorCount, dev);
    (void)hipOccupancyMaxActiveBlocksPerMultiprocessor(&per_cu, mk, NTHREADS, SHM_BYTES);
    grid_blocks = cus;
  }
  (void)hipMemsetAsync((char*)d_ws + OFF_BAR, 0, 256, stream);
  int ph0 = 0, ph1 = NPHASE, coop = 1;
  void* args[] = {&p, &ph0, &ph1, &coop};
  (void)hipLaunchCooperativeKernel((void*)mk, dim3(grid_blocks), dim3(NTHREADS), args, SHM_BYTES, stream);
#else
  for (int ph = 0; ph < NPHASE; ++ph) mk<<<256, NTHREADS, SHM_BYTES, stream>>>(p, ph, ph + 1, 0);
#endif
}
```

```cpp
#include <hip/hip_runtime.h>
#include <hip/hip_cooperative_groups.h>
namespace cg = cooperative_groups;

#ifndef REP_SCAN
#define REP_SCAN 1
#endif
#ifndef REP_POST
#define REP_POST 1
#endif
#ifndef REP_CS
#define REP_CS 1
#endif
#ifndef REP_ZR
#define REP_ZR 1
#endif
#ifndef COOP
#define COOP 1
#endif

typedef _Float16 h16;
typedef _Float16 h16x8 __attribute__((ext_vector_type(8)));
typedef _Float16 h16x4 __attribute__((ext_vector_type(4)));
typedef float f32x4 __attribute__((ext_vector_type(4)));
typedef float f32x2 __attribute__((ext_vector_type(2)));

constexpr int D = 1024, NB = 16, SEQ = 2048, DEPTH = 4, CTX = 256;
constexpr int PIN = 8576, PINP = 8704, RC = 3456;
constexpr int ZRW = 3584;
constexpr int ZOW = 5120;
constexpr int OC_CONV = 0, OC_SGU = 1024, OC_GATE = 2048;
constexpr int DFF = 2816;
constexpr int GB = 4, NG = NB / GB;
constexpr int MLAT = GB * SEQ, MCTX = GB * CTX, MG = MLAT + MCTX;
constexpr int NLAT = NB * SEQ, MALL = NB * (SEQ + CTX);
constexpr int NTHREADS = 512;
constexpr int SHM_BYTES = 131072;
constexpr float YSC = 0.0625f, YUN = 16.0f;

constexpr size_t al256(size_t x) { return (x + 255) / 256 * 256; }
constexpr size_t OFF_MOD = 0;
constexpr size_t OFF_BAR = al256(OFF_MOD + (size_t)4 * 17 * 6144 * 4);
constexpr size_t OFF_CTXX = al256(OFF_BAR + 256);
constexpr size_t OFF_WINT = al256(OFF_CTXX + (size_t)NB * CTX * D * 4);
constexpr size_t OFF_FFNINT = al256(OFF_WINT + (size_t)PINP * D * 2);
constexpr size_t OFF_FFNOUTT = al256(OFF_FFNINT + (size_t)2 * DFF * D * 2);
constexpr size_t OFF_ROUTT = al256(OFF_FFNOUTT + (size_t)D * DFF * 2);
constexpr size_t OFF_WMT = al256(OFF_ROUTT + (size_t)D * D * 2);
constexpr size_t OFF_COUTT = al256(OFF_WMT + (size_t)D * D * 2);
constexpr size_t OFF_SOUTT = al256(OFF_COUTT + (size_t)D * 512 * 2);
constexpr size_t OFF_SGUW = al256(OFF_SOUTT + (size_t)D * 512 * 2);
constexpr size_t OFF_GUPT = al256(OFF_SGUW + (size_t)8 * 128 * 128 * 2);
constexpr size_t OFF_HALL = al256(OFF_GUPT + (size_t)D * 128 * 2);
constexpr size_t OFF_YH = al256(OFF_HALL + (size_t)MALL * D * 2);
constexpr size_t OFF_APRE = OFF_YH;
constexpr size_t OFF_ZR = al256(OFF_YH + (size_t)2 * MALL * D * 2);
constexpr size_t OFF_FFNOUTT2 = al256(OFF_ZR + (size_t)MALL * ZRW * 2);
constexpr size_t WS_TOTAL = al256(OFF_FFNOUTT2 + (size_t)D * DFF * 2);
constexpr size_t ZO_BYTES = (size_t)MG * ZOW * 2;
constexpr size_t OFF_ZO = OFF_ZR;
constexpr size_t OFF_BPRE = al256(OFF_ZO + 2 * ZO_BYTES);
constexpr size_t OFF_CPRE = al256(OFF_BPRE + (size_t)MG * 512 * 2);
constexpr size_t OFF_M16 = al256(OFF_CPRE + (size_t)MG * 512 * 2);
constexpr size_t OFF_HID = OFF_ZR;
static_assert(OFF_M16 + (size_t)MG * D * 2 <= OFF_FFNOUTT2, "group buffers must fit in the ZR region");
static_assert(OFF_HID + (size_t)MALL * DFF * 2 <= OFF_FFNOUTT2, "ffn hidden must fit in the ZR region");

struct P {
  const float* in[35];
  float* out;
  char* ws;
};
typedef const __attribute__((address_space(4))) P CP4;

__device__ __forceinline__ float wave_sum(float v) {
#pragma unroll
  for (int m = 32; m >= 1; m >>= 1) v += __shfl_xor(v, m, 64);
  return v;
}
__device__ __forceinline__ int ltid() { int t = threadIdx.x; asm volatile("" : "+v"(t)); return t; }
__device__ __forceinline__ float sigmoidf_(float x) { return __builtin_amdgcn_rcpf(1.0f + __expf(-x)); }
__device__ __forceinline__ float siluf_(float x) { return x * sigmoidf_(x); }
__device__ __forceinline__ float tanhf_(float x) { return 1.0f - 2.0f * __builtin_amdgcn_rcpf(1.0f + __expf(2.0f * x)); }
__device__ __forceinline__ float geluf_(float x) {
  float u = 0.7978845608028654f * (x + 0.044715f * x * x * x);
  return x * __builtin_amdgcn_rcpf(1.0f + __expf(-2.0f * u));
}
__device__ __forceinline__ float* xrow2(float* out, char* ws, int g, int r) {
  return (r < MLAT) ? out + ((size_t)g * MLAT + r) * D
                    : (float*)(ws + OFF_CTXX) + ((size_t)g * MCTX + (r - MLAT)) * D;
}
__device__ __forceinline__ const float* modrow2(const char* ws, int l, int g, int r) {
  int i = (r < MLAT) ? (g * GB + r / SEQ) : 16;
  return (const float*)(ws + OFF_MOD) + ((size_t)l * 17 + i) * 6144;
}
__device__ __forceinline__ float* xrow(CP4& p, int g, int r) { return xrow2(p.out, p.ws, g, r); }
__device__ __forceinline__ const float* modrow(CP4& p, int l, int g, int r) { return modrow2(p.ws, l, g, r); }
__device__ __forceinline__ void seqposG(int R, int& t, int& L) {
  int lr = R % MG;
  if (lr < MLAT) { t = lr % SEQ; L = SEQ; } else { t = (lr - MLAT) % CTX; L = CTX; }
}
__device__ __forceinline__ float zshift(const h16* Z, const float* sw, int r, int t, int L, int col) {
  float v = (float)Z[(size_t)r * ZRW + col] * sw[RC + col];
  if (t > 0) v += (float)Z[(size_t)(r - 1) * ZRW + col] * sw[col];
  if (t < L - 1) v += (float)Z[(size_t)(r + 1) * ZRW + col] * sw[2 * RC + col];
  return v;
}
__device__ __forceinline__ void grid_bar(unsigned* ctr, unsigned target) {
  asm volatile("s_waitcnt vmcnt(0) lgkmcnt(0)" ::: "memory");
  __syncthreads();
  if (threadIdx.x == 0) {
    __builtin_amdgcn_fence(__ATOMIC_RELEASE, "agent");
    asm volatile("s_waitcnt vmcnt(0)" ::: "memory");
    __hip_atomic_fetch_add(ctr, 1u, __ATOMIC_RELAXED, __HIP_MEMORY_SCOPE_AGENT);
    while (__hip_atomic_load(ctr, __ATOMIC_RELAXED, __HIP_MEMORY_SCOPE_AGENT) < target) __builtin_amdgcn_s_sleep(1);
    __builtin_amdgcn_fence(__ATOMIC_ACQUIRE, "agent");
    asm volatile("s_waitcnt vmcnt(0)" ::: "memory");
  }
  __syncthreads();
}

#define LAS __attribute__((address_space(3)))
constexpr int BM = 256, BK = 64, HALF = 128, HTB = HALF * BK * 2;
__device__ __forceinline__ int lds_byte(int r, int c) {
  int st = (r >> 4) * 2 + (c >> 5), rr = r & 15, cc = c & 31, ob = rr * 64 + cc * 2;
  return st * 1024 + (ob ^ (((ob >> 9) & 1) << 5));
}
__device__ __forceinline__ void stage_rc(int b, int& R, int& C) {
  int st = b / 1024, sb = b % 1024, swz = sb ^ (((sb >> 9) & 1) << 5);
  R = (st >> 1) * 16 + swz / 64; C = (st & 1) * 32 + (swz % 64) / 2;
}
__device__ __forceinline__ bool tile_of(int i, int nM, int nN, int ubeg, int uend, int brot, int nblk, int& pm, int& pn) {
  const int NXCD = 8, WGM = 8;
  int nwg = nM * nN;
  int bsub = (int)blockIdx.x - brot; if (bsub < 0) bsub += gridDim.x;
  if (bsub >= nblk) return false;
  long Lq = (long)ubeg + (long)i * nblk + bsub; if (Lq >= uend) return false;
  int wgid = (int)Lq;
  { int q = nwg / NXCD, r = nwg % NXCD, xcd = wgid % NXCD, off = wgid / NXCD;
    wgid = (xcd < r ? xcd * (q + 1) : r * (q + 1) + (xcd - r) * q) + off; }
  int nig = WGM * nN, gid = wgid / nig, fm = gid * WGM, gsz = min(nM - fm, WGM);
  pm = fm + ((wgid % nig) % gsz); pn = (wgid % nig) / gsz;
  return true;
}

template <class Epi>
__device__ __forceinline__ void gemm_phase(LAS unsigned char* lds, const h16* Ag, const h16* Btg, int K, int row0, int nM, int nN, int ubeg, int uend, int brot, int nblk, const Epi& E) {
  const int tid = threadIdx.x, wid = __builtin_amdgcn_readfirstlane(tid >> 6), lane = tid & 63, wr = wid >> 2, wc = wid & 3, fr = lane & 15, fq = lane >> 4;
  const int nt = K / BK;
  unsigned voffA[2];
#pragma unroll
  for (int i = 0; i < 2; ++i) { int R, C; stage_rc(tid * 16 + i * 8192, R, C); voffA[i] = (unsigned)(R * K + C) * 2u; }
  const size_t kstep = (size_t)(BK * 2);
  const size_t hstep = (size_t)HALF * K * 2;
  const size_t tstep = 2 * hstep;
  const unsigned ldsw = (unsigned)wid * 1024u;
  const int aoff = lds_byte(wr * 64 + fr, fq * 8), boff = lds_byte(wc * 32 + fr, fq * 8);
  const char* Abase = (const char*)(Ag + (size_t)row0 * K);
#define PG8_SA(b, h) (((b) * 2 + (h)) * HTB)
#define PG8_SB(b, h) ((4 + (b) * 2 + (h)) * HTB)
#define PG8_STAGE(bufoff, gbase, voff) do { _Pragma("unroll") for (int _i = 0; _i < 2; ++_i) \
    __builtin_amdgcn_global_load_lds((const unsigned*)((const char*)(gbase) + (voff)[_i]), (LAS unsigned*)(lds + (bufoff) + ldsw + _i * 8192), 16, 0, 0); } while (0)
#define PG8_LDA(dst, b, h) do { _Pragma("unroll") for (int m = 0; m < 4; ++m) _Pragma("unroll") for (int k = 0; k < 2; ++k) dst[m][k] = *(const LAS h16x8*)(lds + PG8_SA(b, h) + aoff + m * 2048 + k * 1024); } while (0)
#define PG8_LDB(dst, b, h) do { _Pragma("unroll") for (int n = 0; n < 2; ++n) _Pragma("unroll") for (int k = 0; k < 2; ++k) dst[n][k] = *(const LAS h16x8*)(lds + PG8_SB(b, h) + boff + n * 2048 + k * 1024); } while (0)
#define PG8_MMA(ai, bj, At, Bt) do { __builtin_amdgcn_s_setprio(1); _Pragma("unroll") for (int m = 0; m < 4; ++m) _Pragma("unroll") for (int n = 0; n < 2; ++n) _Pragma("unroll") for (int k = 0; k < 2; ++k) \
    acc[ai][bj][m][n] = __builtin_amdgcn_mfma_f32_16x16x32_f16(Bt[n][k], At[m][k], acc[ai][bj][m][n], 0, 0, 0); __builtin_amdgcn_s_setprio(0); } while (0)
#define PG8_WAIT_V(n) asm volatile("s_waitcnt vmcnt(" #n ")" ::: "memory")
#define PG8_WAIT_L(n) asm volatile("s_waitcnt lgkmcnt(" #n ")" ::: "memory")
#define PG8_BAR __builtin_amdgcn_s_barrier()
#define PG8_SCHED __builtin_amdgcn_sched_barrier(0)
  int cpm, cpn, npm, npn, ui = 0;
  __syncthreads();
  if (!tile_of(0, nM, nN, ubeg, uend, brot, nblk, cpm, cpn)) return;
  f32x4 acc[2][2][4][2];
#pragma unroll
  for (int a = 0; a < 2; ++a)
#pragma unroll
    for (int b = 0; b < 2; ++b)
#pragma unroll
      for (int m = 0; m < 4; ++m)
#pragma unroll
        for (int n = 0; n < 2; ++n) acc[a][b][m][n] = (f32x4){0.f, 0.f, 0.f, 0.f};
  h16x8 At[4][2], B0[2][2], B1[2][2];
  const char* cA = Abase + (size_t)cpm * tstep; const char* cB = (const char*)Btg + (size_t)cpn * tstep;
  PG8_STAGE(PG8_SB(0, 0), cB, voffA); PG8_STAGE(PG8_SA(0, 0), cA, voffA); PG8_STAGE(PG8_SB(0, 1), cB + hstep, voffA); PG8_STAGE(PG8_SA(0, 1), cA + hstep, voffA);
  if (wr == 1) PG8_BAR;
  PG8_WAIT_V(4); PG8_BAR;
  PG8_STAGE(PG8_SB(1, 0), cB + kstep, voffA); PG8_STAGE(PG8_SA(1, 0), cA + kstep, voffA); PG8_STAGE(PG8_SB(1, 1), cB + hstep + kstep, voffA);
  PG8_WAIT_V(6); PG8_BAR;
  for (;;) {
    const bool has_next = tile_of(ui + 1, nM, nN, ubeg, uend, brot, nblk, npm, npn);
    const char* nA = has_next ? Abase + (size_t)npm * tstep : cA; const char* nB = has_next ? (const char*)Btg + (size_t)npn * tstep : cB;
    for (int t = 0; t < nt; t += 2) {
      const bool last = (t == nt - 2);
      const char* a1 = cA + (size_t)(t + 1) * kstep;
      const char* a2 = last ? nA : cA + (size_t)(t + 2) * kstep; const char* b2 = last ? nB : cB + (size_t)(t + 2) * kstep;
      const char* a3 = a2 + kstep; const char* b3 = b2 + kstep;
      PG8_LDB(B0, 0, 0); PG8_SCHED; PG8_LDA(At, 0, 0); PG8_STAGE(PG8_SA(1, 1), a1 + hstep, voffA);
      PG8_WAIT_L(8); PG8_BAR; PG8_WAIT_L(0); PG8_MMA(0, 0, At, B0); PG8_BAR; PG8_SCHED;
      PG8_LDB(B1, 0, 1); PG8_STAGE(PG8_SB(0, 0), b2, voffA);
      PG8_BAR; PG8_WAIT_L(0); PG8_MMA(0, 1, At, B1); PG8_BAR;
      PG8_LDA(At, 0, 1); PG8_STAGE(PG8_SA(0, 0), a2, voffA);
      PG8_BAR; PG8_WAIT_L(0); PG8_MMA(1, 0, At, B0); PG8_BAR; PG8_SCHED;
      PG8_STAGE(PG8_SB(0, 1), b2 + hstep, voffA);
      PG8_WAIT_V(6); PG8_BAR; PG8_MMA(1, 1, At, B1); PG8_BAR;
      PG8_LDB(B0, 1, 0); PG8_SCHED; PG8_LDA(At, 1, 0); PG8_STAGE(PG8_SA(0, 1), a2 + hstep, voffA);
      PG8_WAIT_L(8); PG8_BAR; PG8_WAIT_L(0); PG8_MMA(0, 0, At, B0); PG8_BAR; PG8_SCHED;
      PG8_LDB(B1, 1, 1); PG8_STAGE(PG8_SB(1, 0), b3, voffA);
      PG8_BAR; PG8_WAIT_L(0); PG8_MMA(0, 1, At, B1); PG8_BAR;
      PG8_LDA(At, 1, 1); PG8_STAGE(PG8_SA(1, 0), a3, voffA);
      PG8_BAR; PG8_WAIT_L(0); PG8_MMA(1, 0, At, B0); PG8_BAR; PG8_SCHED;
      PG8_STAGE(PG8_SB(1, 1), b3 + hstep, voffA);
      PG8_WAIT_V(6); PG8_BAR; PG8_MMA(1, 1, At, B1); PG8_BAR;
    }
    E(acc, row0 + cpm * BM, cpn * BM, wr, wc, fr, fq);
    if (!has_next) break;
#pragma unroll
    for (int a = 0; a < 2; ++a)
#pragma unroll
      for (int b = 0; b < 2; ++b)
#pragma unroll
        for (int m = 0; m < 4; ++m)
#pragma unroll
          for (int n = 0; n < 2; ++n) acc[a][b][m][n] = (f32x4){0.f, 0.f, 0.f, 0.f};
    cpm = npm; cpn = npn; cA = nA; cB = nB; ++ui;
  }
  PG8_WAIT_V(0);
  if (wr == 0) PG8_BAR;
  PG8_BAR;
#undef PG8_SA
#undef PG8_SB
#undef PG8_STAGE
#undef PG8_LDA
#undef PG8_LDB
#undef PG8_MMA
}

struct EpiAny {
  int mode; h16* O16; const h16* Z; float* MT; float* out; char* ws; int l, g, goff, ldo;
  __device__ __forceinline__ void operator()(const f32x4 (&acc)[2][2][4][2], int brow, int bcol, int wr, int wc, int fr, int fq) const {
    if (mode == 0) {
#pragma unroll
      for (int ai = 0; ai < 2; ++ai)
#pragma unroll
        for (int m = 0; m < 4; ++m) {
          int row = brow + ai * 128 + wr * 64 + m * 16 + fr;
#pragma unroll
          for (int bj = 0; bj < 2; ++bj) {
            int col = bcol + bj * 128 + wc * 32 + fq * 8;
            f32x4 a = acc[ai][bj][m][0], b = acc[ai][bj][m][1];
            h16x8 o = {(h16)a[0], (h16)a[1], (h16)a[2], (h16)a[3], (h16)b[0], (h16)b[1], (h16)b[2], (h16)b[3]};
            *(h16x8*)(O16 + (size_t)row * ldo + col) = o;
          }
        }
    } else if (mode <= 3) {
      const int bm = mode - 1;
#pragma unroll
      for (int ai = 0; ai < 2; ++ai) {
        h16x8 gts[4][2], old[4][2];
#pragma unroll
        for (int m = 0; m < 4; ++m) {
          int row = brow + ai * 128 + wr * 64 + m * 16 + fr;
#pragma unroll
          for (int bj = 0; bj < 2; ++bj) {
            int col = bcol + bj * 128 + wc * 32 + fq * 8;
            gts[m][bj] = *(const h16x8*)(Z + (size_t)row * ZOW + OC_GATE + bm * D + col);
            if (bm != 0) old[m][bj] = *(const h16x8*)(O16 + (size_t)row * D + col);
          }
        }
#pragma unroll
        for (int m = 0; m < 4; ++m) {
          int row = brow + ai * 128 + wr * 64 + m * 16 + fr;
#pragma unroll
          for (int bj = 0; bj < 2; ++bj) {
            int col = bcol + bj * 128 + wc * 32 + fq * 8;
            const h16x8 gt = gts[m][bj];
            f32x4 a = acc[ai][bj][m][0], b = acc[ai][bj][m][1];
            float v[8];
#pragma unroll
            for (int j = 0; j < 4; ++j) { v[j] = a[j] * sigmoidf_((float)gt[j]); v[4 + j] = b[j] * sigmoidf_((float)gt[4 + j]); }
            if (bm != 0) {
#pragma unroll
              for (int j = 0; j < 8; ++j) v[j] += (float)old[m][bj][j]; }
            h16x8 hv;
#pragma unroll
            for (int j = 0; j < 8; ++j) hv[j] = (h16)v[j];
            *(h16x8*)(O16 + (size_t)row * D + col) = hv;
          }
        }
      }
    } else if (mode == 4) {
      f32x4 gt[2][2];
      {
        const int gg0 = g + brow / MG, lr0 = brow % MG;
        const float* md = modrow2(ws, l, gg0, lr0) + goff;
#pragma unroll
        for (int bj = 0; bj < 2; ++bj)
#pragma unroll
          for (int n = 0; n < 2; ++n) gt[bj][n] = *(const f32x4*)(md + bcol + bj * 128 + wc * 32 + n * 16 + fq * 4);
      }
#pragma unroll
      for (int ai = 0; ai < 2; ++ai) {
        f32x4 o[4][2][2]; float* xrs[4];
#pragma unroll
        for (int m = 0; m < 4; ++m) {
          int row = brow + ai * 128 + wr * 64 + m * 16 + fr;
          const int gg = g + row / MG, lr = row % MG;
          float* xr = xrow2(out, ws, gg, lr);
          xrs[m] = xr;
#pragma unroll
          for (int bj = 0; bj < 2; ++bj)
#pragma unroll
            for (int n = 0; n < 2; ++n) o[m][bj][n] = *(const f32x4*)(xr + bcol + bj * 128 + wc * 32 + n * 16 + fq * 4);
        }
#pragma unroll
        for (int m = 0; m < 4; ++m)
#pragma unroll
          for (int bj = 0; bj < 2; ++bj)
#pragma unroll
            for (int n = 0; n < 2; ++n)
              *(f32x4*)(xrs[m] + bcol + bj * 128 + wc * 32 + n * 16 + fq * 4) = o[m][bj][n] + gt[bj][n] * acc[ai][bj][m][n];
      }
    } else {
      int hb = (bcol >> 8) * 128;
#pragma unroll
      for (int ai = 0; ai < 2; ++ai)
#pragma unroll
        for (int m = 0; m < 4; ++m) {
          int row = brow + ai * 128 + wr * 64 + m * 16 + fr;
          int col = hb + wc * 32 + fq * 8;
          h16x8 o;
#pragma unroll
          for (int n = 0; n < 2; ++n) {
            f32x4 a = acc[ai][0][m][n], b = acc[ai][1][m][n];
#pragma unroll
            for (int j = 0; j < 4; ++j) o[n * 4 + j] = (h16)(siluf_(a[j]) * b[j]);
          }
          *(h16x8*)(O16 + (size_t)row * DFF + col) = o;
        }
    }
  }
};

__device__ __forceinline__ void phase_mod(CP4& p, float* sm) {
  float* SC = sm;
  float* RED = sm + 17 * 1024;
  int tid = ltid();
  for (int u = blockIdx.x; u < 4 * 48; u += gridDim.x) {
    int l = u / 48, cb = (u % 48) * 128;
    __syncthreads();
    for (int e = tid; e < 17 * 1024; e += NTHREADS) {
      int i = e >> 10, k = e & 1023;
      float c = (i < 16) ? p.in[1][i * 1024 + k] : p.in[3][k];
      SC[e] = siluf_(c);
    }
    __syncthreads();
    int cj = tid & 127, kq = tid >> 7;
    const float* W = p.in[4] + (size_t)l * 1024 * 6144 + cb + cj;
    float acc[17];
#pragma unroll
    for (int i = 0; i < 17; ++i) acc[i] = 0.f;
    for (int k = kq * 256; k < kq * 256 + 256; k += 4) {
      float w0 = W[(size_t)k * 6144], w1 = W[(size_t)(k + 1) * 6144], w2 = W[(size_t)(k + 2) * 6144], w3 = W[(size_t)(k + 3) * 6144];
#pragma unroll
      for (int i = 0; i < 17; ++i) {
        float4 s = *(const float4*)(SC + i * 1024 + k);
        acc[i] += s.x * w0 + s.y * w1 + s.z * w2 + s.w * w3;
      }
    }
#pragma unroll
    for (int i = 0; i < 17; ++i) RED[(kq * 17 + i) * 128 + cj] = acc[i];
    __syncthreads();
    if (kq == 0) {
      float* MO = (float*)(p.ws + OFF_MOD);
      float b = p.in[5][l * 6144 + cb + cj];
#pragma unroll
      for (int i = 0; i < 17; ++i) {
        float v = RED[(0 * 17 + i) * 128 + cj] + RED[(1 * 17 + i) * 128 + cj] + RED[(2 * 17 + i) * 128 + cj] + RED[(3 * 17 + i) * 128 + cj];
        MO[((size_t)l * 17 + i) * 6144 + cb + cj] = v + b;
      }
    }
  }
}

__device__ __forceinline__ void phase_copyx(CP4& p) {
  size_t n1 = (size_t)NB * SEQ * D / 4, n2 = (size_t)NB * CTX * D / 4;
  const float4* s1 = (const float4*)p.in[0]; float4* d1 = (float4*)p.out;
  const float4* s2 = (const float4*)p.in[2]; float4* d2 = (float4*)(p.ws + OFF_CTXX);
  size_t stride = (size_t)gridDim.x * NTHREADS;
  for (size_t i = (size_t)blockIdx.x * NTHREADS + ltid(); i < n1; i += stride) d1[i] = s1[i];
  for (size_t i = (size_t)blockIdx.x * NTHREADS + ltid(); i < n2; i += stride) d2[i] = s2[i];
}

__device__ __forceinline__ int perm32(int rho) { const int n = rho >> 4, i = rho & 15; return 8 * (i >> 2) + 4 * n + (i & 3); }
__device__ __forceinline__ void tr_job(const float* src, int K, int Nsrc, h16* dst, int Ndst, int mode, bool perm, float* T, int b0, int nb) {
  int tk = K / 64, tn = Ndst / 64;
  int tid = ltid();
  if ((int)blockIdx.x < b0) return;
  const int lk = tid >> 4, lc = (tid & 15) * 4;
  const int sn = tid >> 3, sk = (tid & 7) * 8;
  const int ln = perm ? ((sn & 32) + perm32(sn & 31)) : sn;
  for (int u = blockIdx.x - b0; u < tk * tn; u += nb) {
    int k0 = (u % tk) * 64, n0 = (u / tk) * 64;
    int sn0;
    if (mode == 1) { int pn = n0 >> 8, j = n0 & 255; sn0 = (j < 128) ? pn * 128 + j : DFF + pn * 128 + (j - 128); }
    else if (mode == 2) sn0 = (n0 < RC) ? n0 : (n0 < ZRW ? Nsrc : n0 - (ZRW - RC));
    else sn0 = n0;
    bool valid = sn0 < Nsrc;
    f32x4 v0 = {0.f, 0.f, 0.f, 0.f}, v1 = {0.f, 0.f, 0.f, 0.f};
    if (valid) {
      v0 = *(const f32x4*)(src + (size_t)(k0 + lk) * Nsrc + sn0 + lc);
      v1 = *(const f32x4*)(src + (size_t)(k0 + lk + 32) * Nsrc + sn0 + lc);
    }
    __syncthreads();
    *(f32x4*)(T + lk * 68 + lc) = v0;
    *(f32x4*)(T + (lk + 32) * 68 + lc) = v1;
    __syncthreads();
    h16x8 o;
#pragma unroll
    for (int e = 0; e < 8; ++e) o[e] = (h16)T[(sk + e) * 68 + ln];
    *(h16x8*)(dst + (size_t)(n0 + sn) * K + k0 + sk) = o;
  }
}
__device__ __forceinline__ void phase_convert(CP4& p, int l, float* sm, int b0, int nb) {
  tr_job(p.in[8] + (size_t)l * D * PIN, D, PIN, (h16*)(p.ws + OFF_WINT), PINP, 2, true, sm, b0, nb);
  tr_job(p.in[32] + (size_t)l * D * 2 * DFF, D, 2 * DFF, (h16*)(p.ws + OFF_FFNINT), 2 * DFF, 1, true, sm, b0, nb);
  tr_job(p.in[33] + (size_t)l * DFF * D, DFF, D, (h16*)(p.ws + ((l & 1) ? OFF_FFNOUTT2 : OFF_FFNOUTT)), D, 0, false, sm, b0, nb);
  tr_job(p.in[20] + (size_t)l * D * D, D, D, (h16*)(p.ws + OFF_ROUTT), D, 0, true, sm, b0, nb);
  tr_job(p.in[31] + (size_t)l * D * D, D, D, (h16*)(p.ws + OFF_WMT), D, 0, false, sm, b0, nb);
  tr_job(p.in[25] + (size_t)l * 512 * D, 512, D, (h16*)(p.ws + OFF_COUTT), D, 0, true, sm, b0, nb);
  tr_job(p.in[30] + (size_t)l * 512 * D, 512, D, (h16*)(p.ws + OFF_SOUTT), D, 0, true, sm, b0, nb);
  tr_job(p.in[14] + (size_t)l * 128 * D, 128, D, (h16*)(p.ws + OFF_GUPT), D, 0, false, sm, b0, nb);
  if ((int)blockIdx.x < b0) return;
  const float* sw = p.in[28] + (size_t)l * 8 * 128 * 128;
  h16* dw = (h16*)(p.ws + OFF_SGUW);
  for (int i = (blockIdx.x - b0) * NTHREADS + ltid(); i < 8 * 128 * 128; i += nb * NTHREADS) dw[i] = (h16)sw[i];
}

__device__ __forceinline__ void phase_norm(CP4& p, int l, int which) {
  const float* gam = p.in[which ? 7 : 6] + l * D;
  h16* H = (h16*)(p.ws + OFF_HALL);
  int tid_ = ltid(); int lane = tid_ & 63, wv = tid_ >> 6;
  for (int r = blockIdx.x * 8 + wv; r < MALL; r += gridDim.x * 8) {
    int g = r / MG, lr = r % MG;
    const float* x = xrow(p, g, lr);
    const float* md = modrow(p, l, g, lr) + which * 3072;
    f32x4 v[4]; float ss = 0.f;
#pragma unroll
    for (int i = 0; i < 4; ++i) { v[i] = *(const f32x4*)(x + i * 256 + lane * 4); ss += v[i][0] * v[i][0] + v[i][1] * v[i][1] + v[i][2] * v[i][2] + v[i][3] * v[i][3]; }
    ss = wave_sum(ss);
    float rs = rsqrtf(ss * (1.0f / D) + 1e-6f);
#pragma unroll
    for (int i = 0; i < 4; ++i) {
      int c = i * 256 + lane * 4;
      f32x4 gm = *(const f32x4*)(gam + c), sh = *(const f32x4*)(md + c), sc = *(const f32x4*)(md + D + c);
      h16x4 o;
#pragma unroll
      for (int j = 0; j < 4; ++j) o[j] = (h16)((v[i][j] * rs * gm[j]) * (1.0f + sc[j]) + sh[j]);
      *(h16x4*)(H + (size_t)r * D + c) = o;
    }
  }
}

__device__ __forceinline__ void phase_final(CP4& p) {
  const float* gam = p.in[34];
  int tid_ = ltid(); int lane = tid_ & 63, wv = tid_ >> 6;
  for (int r = blockIdx.x * 8 + wv; r < NB * SEQ; r += gridDim.x * 8) {
    float* x = p.out + (size_t)r * D;
    f32x4 v[4]; float ss = 0.f;
#pragma unroll
    for (int i = 0; i < 4; ++i) { v[i] = *(const f32x4*)(x + i * 256 + lane * 4); ss += v[i][0] * v[i][0] + v[i][1] * v[i][1] + v[i][2] * v[i][2] + v[i][3] * v[i][3]; }
    ss = wave_sum(ss);
    float rs = rsqrtf(ss * (1.0f / D) + 1e-6f);
#pragma unroll
    for (int i = 0; i < 4; ++i) {
      int c = i * 256 + lane * 4;
      f32x4 gm = *(const f32x4*)(gam + c);
      f32x4 o = v[i] * rs * gm;
      *(f32x4*)(x + c) = o;
    }
  }
}

typedef unsigned u32x4 __attribute__((ext_vector_type(4)));
#define FMIX_LO(acc, m, u) asm("v_fma_mix_f32 %0, %1, %2, %0 op_sel:[0,0,0] op_sel_hi:[1,0,0]" : "+v"(acc) : "v"(m), "v"(u))
#define FMIX_HI(acc, m, u) asm("v_fma_mix_f32 %0, %1, %2, %0 op_sel:[1,0,0] op_sel_hi:[1,0,0]" : "+v"(acc) : "v"(m), "v"(u))
constexpr int TC = 16;
constexpr int SD_R = 0, SD_K = 4096, SD_V = 8192, SD_KKA = 12288, SD_LW = 16384, SD_LA = 18688, SD_RN = 20992, SD_RAW = 21120;
constexpr int SD_KK = SD_RAW, SD_W = SD_RAW + 4096;
constexpr int SD_AM = 32640, SD_BM = SD_AM + 2304, SD_CM = SD_BM + 2304, SD_RM = SD_CM + 2304;
constexpr int SD_BT = SD_RM + 2304, SD_CT = SD_BT + 3072, SD_VT = SD_CT + 3072;
constexpr int SD_WS = SD_VT + 3072, SD_WE = SD_WS + 256;
constexpr int SD_MCA = SD_WE + 256, SD_NBR = SD_MCA + 768, SD_NCR = SD_NBR + 768;
constexpr int SD_MBT = SD_NCR + 768;
constexpr int SD_XS = SD_MBT + 768;
constexpr int SD_SIZE = SD_XS + 4 * 1280;
static_assert(2 * SD_SIZE <= SHM_BYTES, "scan LDS layout");
constexpr int LWS = 72;
constexpr int TS = 24;
__device__ __forceinline__ void scan_chunk_geom(int c, int d, int bl, int& L, int& t0, int& rbase) {
  const int gb = (bl >> 2) * MG, b4 = bl & 3;
  if (c < CTX / TC) { L = CTX; t0 = d ? (CTX - TC * (c + 1)) : TC * c; rbase = gb + MLAT + b4 * CTX; }
  else { int cc = c - CTX / TC; L = SEQ; t0 = d ? (SEQ - TC * (cc + 1)) : TC * cc; rbase = gb + b4 * SEQ; }
}
__device__ __forceinline__ void scan_pair(CP4& p, int l, int bl, int hh, char* smc) {
  const h16* Z = (const h16*)(p.ws + OFF_ZR);
  h16* Y = (h16*)(p.ws + OFF_YH);
  const int tid = ltid(), lane = tid & 63, wv = __builtin_amdgcn_readfirstlane(tid >> 6), d = wv >> 2, wq = wv & 3, td = tid & 255;
  char* sd = smc + d * SD_SIZE;
  float* AR = (float*)(sd + SD_R); float* AK = (float*)(sd + SD_K); float* AV = (float*)(sd + SD_V);
  float* AKA = (float*)(sd + SD_KKA); float* AKK = (float*)(sd + SD_KK); float* AW = (float*)(sd + SD_W);
  float* RN = (float*)(sd + SD_RN);
  h16* LW = (h16*)(sd + SD_LW); h16* LA = (h16*)(sd + SD_LA);
  h16* AM = (h16*)(sd + SD_AM); h16* BM = (h16*)(sd + SD_BM); h16* CM = (h16*)(sd + SD_CM); h16* RM = (h16*)(sd + SD_RM);
  h16* BT = (h16*)(sd + SD_BT); h16* CT = (h16*)(sd + SD_CT); h16* VT = (h16*)(sd + SD_VT);
  float* WSC = (float*)(sd + SD_WS); float* WEC = (float*)(sd + SD_WE);
  h16* MCA = (h16*)(sd + SD_MCA); h16* NBR = (h16*)(sd + SD_NBR); h16* NCR = (h16*)(sd + SD_NCR);
  h16* MBT = (h16*)(sd + SD_MBT);
  float* XS = (float*)(sd + SD_XS + wq * 1280);
  const bool act1 = td < 240;
  const int c16 = td % 40, tk0 = td / 40, seg = c16 >> 3, cg = c16 & 7;
  const int segcol = ((seg < 3) ? seg * D + hh * 64 : (seg == 3 ? 3072 + d * 64 : 3200 + d * 64)) + cg * 8;
  const int cgA = lane & 7, tsA = lane >> 3;
  h16x8 swA0, swA1, swA2, swB0, swB1, swB2, kk8;
  {
    const int colA = ((wq < 3) ? wq * D + hh * 64 : 3072 + d * 64) + cgA * 8, colB = 3200 + d * 64 + cgA * 8;
    const float* sw = p.in[9] + (size_t)l * 3 * RC;
    const float* kkp = p.in[15] + l * D + hh * 64 + cgA * 8;
#pragma unroll
    for (int j = 0; j < 8; ++j) {
      swA0[j] = (h16)sw[colA + j]; swA1[j] = (h16)sw[RC + colA + j]; swA2[j] = (h16)sw[2 * RC + colA + j];
      swB0[j] = (h16)sw[colB + j]; swB1[j] = (h16)sw[RC + colB + j]; swB2[j] = (h16)sw[2 * RC + colB + j];
      kk8[j] = (h16)kkp[j];
    }
  }
  const int fr = lane & 15, fq = lane >> 4, jc = 16 * wq + fr;
  const float w0j = p.in[10][((size_t)l * 2 + d) * D + hh * 64 + jc];
  const float a0j = p.in[12][((size_t)l * 2 + d) * D + hh * 64 + jc];
  const float kkj = p.in[15][l * D + hh * 64 + jc];
  const float kaj = p.in[16][l * D + hh * 64 + jc];
  h16x8 Bw[2], Ba[2];
  {
    const float* wup = p.in[11] + ((size_t)l * 2 + d) * 64 * D + hh * 64 + jc;
    const float* aup = p.in[13] + ((size_t)l * 2 + d) * 64 * D + hh * 64 + jc;
#pragma unroll
    for (int ks = 0; ks < 2; ++ks)
#pragma unroll
      for (int jj = 0; jj < 8; ++jj) {
        int i = ks * 32 + fq * 8 + jj;
        Bw[ks][jj] = (h16)wup[(size_t)i * D];
        Ba[ks][jj] = (h16)aup[(size_t)i * D];
      }
  }
  f32x4 T[4];
#pragma unroll
  for (int n = 0; n < 4; ++n) T[n] = (f32x4){0.f, 0.f, 0.f, 0.f};
  const h16x8 zero8 = {0, 0, 0, 0, 0, 0, 0, 0};
  const int NCH = (CTX + SEQ) / TC;
  h16x8 pre[3];
#define RAW_LOAD(cn) do { int L_, t0_, rb_; scan_chunk_geom(cn, d, bl, L_, t0_, rb_); \
    _Pragma("unroll") for (int it = 0; it < 3; ++it) { const int row = tk0 + 6 * it; h16x8 v_ = {0, 0, 0, 0, 0, 0, 0, 0}; \
      if (act1) { int t_ = t0_ - 1 + row; \
        if (t_ >= 0 && t_ < L_) v_ = *(const h16x8*)(Z + (size_t)(rb_ + t_) * ZRW + segcol); } \
      pre[it] = v_; } } while (0)
#define RAW_STORE() do { _Pragma("unroll") for (int it = 0; it < 3; ++it) { const int row = tk0 + 6 * it; \
      if (act1) *(h16x8*)(sd + SD_RAW + row * 640 + c16 * 16) = pre[it]; } } while (0)
  __syncthreads();
  RAW_LOAD(0);
  RAW_STORE();
  __syncthreads();
#pragma unroll 1
  for (int c = 0; c < NCH; ++c) {
    int L, t0, rbase; scan_chunk_geom(c, d, bl, L, t0, rbase);
#pragma unroll
    for (int it = 0; it < 2; ++it) {
      const int tok = tsA + 8 * it;
      const char* rp = sd + SD_RAW + tok * 640 + (wq * 8 + cgA) * 16;
      const h16x8 ra = *(const h16x8*)rp, rb = *(const h16x8*)(rp + 640), rc = *(const h16x8*)(rp + 1280);
      float v[8];
#pragma unroll
      for (int j = 0; j < 8; ++j) v[j] = (float)ra[j] * (float)swA0[j] + (float)rb[j] * (float)swA1[j] + (float)rc[j] * (float)swA2[j];
      if (wq < 3) {
        float* dst = (wq == 0 ? AR : (wq == 1 ? AK : AV)) + tok * 64 + cgA * 8;
        *(float4*)dst = make_float4(v[0], v[1], v[2], v[3]);
        *(float4*)(dst + 4) = make_float4(v[4], v[5], v[6], v[7]);
        if (wq == 1) {
          float ss = 0.f;
#pragma unroll
          for (int j = 0; j < 8; ++j) { float t_ = v[j] * (float)kk8[j]; ss += t_ * t_; }
          ss += __shfl_xor(ss, 1, 64); ss += __shfl_xor(ss, 2, 64); ss += __shfl_xor(ss, 4, 64);
          if (cgA == 0) RN[tok] = rsqrtf(fmaxf(ss, 1e-24f));
        }
      } else {
        h16x8 o;
#pragma unroll
        for (int j = 0; j < 8; ++j) o[j] = (h16)tanhf_(v[j]);
        *(h16x8*)(LW + tok * LWS + cgA * 8) = o;
      }
    }
    if (lane < 32) {
      const int tok = tsA + 4 * wq;
      const char* rp = sd + SD_RAW + tok * 640 + (32 + cgA) * 16;
      const h16x8 ra = *(const h16x8*)rp, rb = *(const h16x8*)(rp + 640), rc = *(const h16x8*)(rp + 1280);
      h16x8 o;
#pragma unroll
      for (int j = 0; j < 8; ++j) o[j] = (h16)((float)ra[j] * (float)swB0[j] + (float)rb[j] * (float)swB1[j] + (float)rc[j] * (float)swB2[j]);
      *(h16x8*)(LA + tok * LWS + cgA * 8) = o;
    }
    __syncthreads();
    {
      f32x4 cw = {0.f, 0.f, 0.f, 0.f}, ca = {0.f, 0.f, 0.f, 0.f};
#pragma unroll
      for (int ks = 0; ks < 2; ++ks) {
        h16x8 alw = *(const h16x8*)(LW + fr * LWS + ks * 32 + fq * 8);
        h16x8 ala = *(const h16x8*)(LA + fr * LWS + ks * 32 + fq * 8);
        cw = __builtin_amdgcn_mfma_f32_16x16x32_f16(alw, Bw[ks], cw, 0, 0, 0);
        ca = __builtin_amdgcn_mfma_f32_16x16x32_f16(ala, Ba[ks], ca, 0, 0, 0);
      }
#pragma unroll
      for (int rg = 0; rg < 4; ++rg) {
        int tok = fq * 4 + rg;
        float dec = __expf(-0.6065306597126334f * sigmoidf_(cw[rg] + w0j));
        float a = sigmoidf_(ca[rg] + a0j);
        float k = AK[tok * 64 + jc];
        float kk = k * kkj * RN[tok];
        AKK[tok * 64 + jc] = kk;
        AKA[tok * 64 + jc] = kk * a;
        AW[tok * 64 + jc] = dec;
        AK[tok * 64 + jc] = k * (1.0f + (a - 1.0f) * kaj);
      }
    }
    if (c + 1 < NCH) RAW_LOAD(c + 1);
    __syncthreads();
    {
      float wref = 1.0f;
#pragma unroll
      for (int s = 0; s < 8; ++s) wref *= AW[(d ? (TC - 1 - s) : s) * 64 + lane];
      float qprev = __builtin_amdgcn_rcpf(wref);
      if (wq == 0) {
#pragma unroll
        for (int s = 0; s < TC; ++s) {
          const int tok = d ? (TC - 1 - s) : s;
          AM[s * LWS + lane] = (h16)(qprev * AKK[tok * 64 + lane]);
          qprev *= AW[tok * 64 + lane];
        }
      } else if (wq == 1) {
#pragma unroll
        for (int s = 0; s < TC; ++s) {
          const int tok = d ? (TC - 1 - s) : s;
          qprev *= AW[tok * 64 + lane];
          const h16 hb = (h16)(AKA[tok * 64 + lane] * __builtin_amdgcn_rcpf(qprev));
          BM[s * LWS + lane] = hb; BT[lane * TS + s] = -hb;
        }
      } else if (wq == 2) {
#pragma unroll
        for (int s = 0; s < TC; ++s) {
          const int tok = d ? (TC - 1 - s) : s;
          qprev *= AW[tok * 64 + lane];
          const h16 hc = (h16)(AK[tok * 64 + lane] * __builtin_amdgcn_rcpf(qprev));
          CM[s * LWS + lane] = hc; CT[lane * TS + s] = hc;
        }
      } else {
        WSC[lane] = wref;
#pragma unroll
        for (int s = 0; s < TC; ++s) {
          const int tok = d ? (TC - 1 - s) : s;
          qprev *= AW[tok * 64 + lane];
          RM[s * LWS + lane] = (h16)(qprev * AR[tok * 64 + lane]);
          VT[lane * TS + s] = (h16)AV[tok * 64 + lane];
        }
        WEC[lane] = qprev;
      }
    }
    __syncthreads();
    if (c + 1 < NCH) RAW_STORE();
    f32x4 P1 = {0.f, 0.f, 0.f, 0.f}, P2 = {0.f, 0.f, 0.f, 0.f};
    {
#pragma unroll
      for (int tt = 0; tt < 4; ++tt) { f32x4 sc = *(const f32x4*)(WSC + tt * 16 + fq * 4); T[tt] = T[tt] * sc; }
#pragma unroll
      for (int ks = 0; ks < 2; ++ks) {
        h16x8 tb;
#pragma unroll
        for (int e = 0; e < 4; ++e) { tb[e] = (h16)T[2 * ks][e]; tb[4 + e] = (h16)T[2 * ks + 1][e]; }
        const h16* ap = AM + fr * LWS + ks * 32 + fq * 4;
        const h16* rp = RM + fr * LWS + ks * 32 + fq * 4;
        h16x4 a0 = *(const h16x4*)ap, a1 = *(const h16x4*)(ap + 16), r0 = *(const h16x4*)rp, r1 = *(const h16x4*)(rp + 16);
        h16x8 af = {a0[0], a0[1], a0[2], a0[3], a1[0], a1[1], a1[2], a1[3]};
        h16x8 rf = {r0[0], r0[1], r0[2], r0[3], r1[0], r1[1], r1[2], r1[3]};
        P1 = __builtin_amdgcn_mfma_f32_16x16x32_f16(af, tb, P1, 0, 0, 0);
        P2 = __builtin_amdgcn_mfma_f32_16x16x32_f16(rf, tb, P2, 0, 0, 0);
      }
      const h16* lhs = (wq & 1) ? CM : BM;
      const h16* rhs = (wq & 2) ? RM : AM;
      f32x4 m = {0.f, 0.f, 0.f, 0.f};
#pragma unroll
      for (int ks = 0; ks < 2; ++ks) {
        h16x8 lf = *(const h16x8*)(lhs + fr * LWS + ks * 32 + fq * 8);
        h16x8 gf = *(const h16x8*)(rhs + fr * LWS + ks * 32 + fq * 8);
        m = __builtin_amdgcn_mfma_f32_16x16x32_f16(lf, gf, m, 0, 0, 0);
      }
#pragma unroll
      for (int r = 0; r < 4; ++r) { const int j = 4 * fq + r; const bool keep = (wq & 2) ? (j <= fr) : (j < fr); m[r] = keep ? m[r] : 0.f; }
      {
        if (wq == 0 || wq == 2) m = -m;
        h16x4 mh = {(h16)m[0], (h16)m[1], (h16)m[2], (h16)m[3]};
        *(h16x4*)((wq == 0 ? MBT : (wq == 1 ? MCA : (wq == 2 ? NBR : NCR))) + fr * TS + fq * 4) = mh;
      }
    }
    __syncthreads();
    {
      const bool lo2 = fq < 2;
      const h16x8 vf = lo2 ? *(const h16x8*)(VT + (wq * 16 + fr) * TS + fq * 8) : zero8;
      const h16x8 mcf = lo2 ? *(const h16x8*)(MCA + fr * TS + fq * 8) : zero8;
      f32x4 Xv = __builtin_amdgcn_mfma_f32_16x16x32_f16(mcf, vf, P1, 0, 0, 0);
      f32x4 ufin = {0.f, 0.f, 0.f, 0.f};
      {
        const h16x4 d1 = *(const h16x4*)(MBT + (4 * fq + 1) * TS + 4 * fq);
        const h16x4 d2 = *(const h16x4*)(MBT + (4 * fq + 2) * TS + 4 * fq);
        const h16x4 d3 = *(const h16x4*)(MBT + (4 * fq + 3) * TS + 4 * fq);
        const h16x4 ma = *(const h16x4*)(MBT + fr * TS + 4 * fq);
        const h16x8 maf = {ma[0], ma[1], ma[2], ma[3], 0, 0, 0, 0};
#pragma unroll
        for (int blk = 0; blk < 4; ++blk) {
          const float u0 = Xv[0];
          const float u1 = Xv[1] + (float)d1[0] * u0;
          const float u2 = Xv[2] + (float)d2[0] * u0 + (float)d2[1] * u1;
          const float u3 = Xv[3] + (float)d3[0] * u0 + (float)d3[1] * u1 + (float)d3[2] * u2;
          const bool mine = (fq == blk);
          ufin[0] = mine ? u0 : ufin[0]; ufin[1] = mine ? u1 : ufin[1]; ufin[2] = mine ? u2 : ufin[2]; ufin[3] = mine ? u3 : ufin[3];
          if (blk < 3) {
            const h16x8 ub = {(h16)u0, (h16)u1, (h16)u2, (h16)u3, 0, 0, 0, 0};
            Xv = __builtin_amdgcn_mfma_f32_16x16x32_f16(maf, mine ? ub : zero8, Xv, 0, 0, 0);
          }
        }
      }
      const h16x8 uf = {(h16)ufin[0], (h16)ufin[1], (h16)ufin[2], (h16)ufin[3], 0, 0, 0, 0};
      const h16x4 nb4 = *(const h16x4*)(NBR + fr * TS + 4 * fq);
      const h16x8 nbf = {nb4[0], nb4[1], nb4[2], nb4[3], 0, 0, 0, 0};
      const h16x8 ncf = lo2 ? *(const h16x8*)(NCR + fr * TS + fq * 8) : zero8;
      f32x4 Yv = __builtin_amdgcn_mfma_f32_16x16x32_f16(nbf, uf, P2, 0, 0, 0);
      Yv = __builtin_amdgcn_mfma_f32_16x16x32_f16(ncf, vf, Yv, 0, 0, 0);
      {
        h16* yb = Y + ((size_t)d * MALL + rbase + t0) * D + hh * 64 + wq * 16 + fr;
#pragma unroll
        for (int r = 0; r < 4; ++r) { const int s = 4 * fq + r; const int tok = d ? (TC - 1 - s) : s; yb[(size_t)tok * D] = (h16)(Yv[r] * YSC); }
      }
#pragma unroll
      for (int tt = 0; tt < 4; ++tt) {
        const h16x4 bt4 = *(const h16x4*)(BT + (tt * 16 + fr) * TS + fq * 4);
        const h16x8 btf = {bt4[0], bt4[1], bt4[2], bt4[3], 0, 0, 0, 0};
        const h16x8 ctf = lo2 ? *(const h16x8*)(CT + (tt * 16 + fr) * TS + fq * 8) : zero8;
        T[tt] = __builtin_amdgcn_mfma_f32_16x16x32_f16(btf, uf, T[tt], 0, 0, 0);
        T[tt] = __builtin_amdgcn_mfma_f32_16x16x32_f16(ctf, vf, T[tt], 0, 0, 0);
        f32x4 sc = *(const f32x4*)(WEC + tt * 16 + fq * 4);
        T[tt] = T[tt] * sc;
      }
    }
  }
#undef RAW_LOAD
#undef RAW_STORE
}

__device__ __forceinline__ void conv_unit(CP4& p, int l, int g, int rowbase, int stride, int L, int p0, char* smc) {
  const h16* Z = (const h16*)(p.ws + OFF_ZO + (size_t)(g & 1) * ZO_BYTES);
  h16* BP = (h16*)(p.ws + OFF_BPRE);
  h16* U = (h16*)smc;
  float* Yc = (float*)(smc + 62 * 512 * 2);
  int tid = ltid(), lane = tid & 63, wv = tid >> 6;
  __syncthreads();
#pragma unroll
  for (int i8 = 0; i8 < 8; ++i8) {
    const int pp = wv + 8 * i8;
    if (pp >= 62) break;
    int pos = p0 - 15 + pp;
    h16x8 o;
    if (pos >= 0 && pos < L) {
      size_t r = (size_t)(rowbase + pos * stride);
      h16x8 a = *(const h16x8*)(Z + r * ZOW + OC_CONV + lane * 8);
      h16x8 b = *(const h16x8*)(Z + r * ZOW + OC_CONV + 512 + lane * 8);
#pragma unroll
      for (int j = 0; j < 8; ++j) o[j] = (h16)((float)a[j] * sigmoidf_((float)b[j]));
    } else {
#pragma unroll
      for (int j = 0; j < 8; ++j) o[j] = (h16)0.f;
    }
    *(h16x8*)(U + pp * 512 + lane * 8) = o;
  }
  __syncthreads();
  {
    const float* dw = p.in[21] + (size_t)l * 31 * 512 + tid;
    float w[31];
#pragma unroll
    for (int j = 0; j < 31; ++j) w[j] = dw[j * 512];
    float bias = p.in[22][l * 512 + tid];
    float uin[62];
#pragma unroll
    for (int pp = 0; pp < 62; ++pp) uin[pp] = (float)U[pp * 512 + tid];
#pragma unroll
    for (int pp = 0; pp < 32; ++pp) {
      float acc = bias;
#pragma unroll
      for (int j = 0; j < 31; ++j) acc += uin[pp + j] * w[j];
      Yc[pp * 512 + tid] = acc;
    }
  }
  __syncthreads();
  const float* lg = p.in[23] + l * 512 + lane * 8;
  const float* lb = p.in[24] + l * 512 + lane * 8;
  for (int pp = wv; pp < 32; pp += 8) {
    float v[8]; float s = 0.f;
#pragma unroll
    for (int j = 0; j < 8; ++j) { v[j] = Yc[pp * 512 + lane * 8 + j]; s += v[j]; }
    float mean = wave_sum(s) * (1.0f / 512);
    float s2 = 0.f;
#pragma unroll
    for (int j = 0; j < 8; ++j) { v[j] -= mean; s2 += v[j] * v[j]; }
    float rstd = rsqrtf(wave_sum(s2) * (1.0f / 512) + 1e-5f);
    h16x8 o;
#pragma unroll
    for (int j = 0; j < 8; ++j) { float t = v[j] * rstd * lg[j] + lb[j]; o[j] = (h16)siluf_(t); }
    size_t r = (size_t)(rowbase + (p0 + pp) * stride);
    *(h16x8*)(BP + r * 512 + lane * 8) = o;
  }
}

__device__ __forceinline__ void sgu_unit(CP4& p, int l, int g, int row0, char* smc) {
  const h16* Z = (const h16*)(p.ws + OFF_ZO + (size_t)(g & 1) * ZO_BYTES);
  h16* CP = (h16*)(p.ws + OFF_CPRE);
  const h16* SW = (const h16*)(p.ws + OFF_SGUW);
  float* MEAN = (float*)smc;
  float* RSTD = MEAN + 128;
  h16* VT = (h16*)(smc + 1024);
  const int tid = ltid(), lane = tid & 63, wv = tid >> 6, fr = lane & 15, fq = lane >> 4;
  __syncthreads();
#pragma unroll 1
  for (int t4 = 0; t4 < 4; ++t4) {
    float s[4], s2[4];
#pragma unroll
    for (int k = 0; k < 4; ++k) {
      int tk = wv * 16 + t4 * 4 + k;
      h16x8 a = *(const h16x8*)(Z + (size_t)(row0 + tk) * ZOW + OC_SGU + 512 + lane * 8);
      s[k] = 0.f; s2[k] = 0.f;
#pragma unroll
      for (int j = 0; j < 8; ++j) { float v = geluf_((float)a[j]); s[k] += v; s2[k] += v * v; }
    }
#pragma unroll
    for (int m = 32; m >= 1; m >>= 1)
#pragma unroll
      for (int k = 0; k < 4; ++k) { s[k] += __shfl_xor(s[k], m, 64); s2[k] += __shfl_xor(s2[k], m, 64); }
    if (lane == 0) {
#pragma unroll
      for (int k = 0; k < 4; ++k) {
        float mean = s[k] * (1.0f / 512);
        float var = fmaxf(s2[k] * (1.0f / 512) - mean * mean, 0.f);
        MEAN[wv * 16 + t4 * 4 + k] = mean; RSTD[wv * 16 + t4 * 4 + k] = rsqrtf(var + 1e-5f);
      }
    }
  }
  __syncthreads();
  const float* lg = p.in[26] + l * 512;
  const float* lb = p.in[27] + l * 512;
  const float* bs = p.in[29] + (size_t)l * 8 * 128;
#pragma unroll 1
  for (int g8 = 0; g8 < 8; ++g8) {
    {
      const int qk = tid & 127, d0 = (tid >> 7) * 16;
      const float mean = MEAN[qk], rstd = RSTD[qk];
      const h16* src = Z + (size_t)(row0 + qk) * ZOW + OC_SGU + 512 + g8 * 64 + d0;
      h16x8 a0 = *(const h16x8*)src, a1 = *(const h16x8*)(src + 8);
#pragma unroll
      for (int j = 0; j < 8; ++j) {
        int c0 = g8 * 64 + d0 + j, c1 = c0 + 8;
        float v0 = (geluf_((float)a0[j]) - mean) * rstd * lg[c0] + lb[c0];
        float v1 = (geluf_((float)a1[j]) - mean) * rstd * lg[c1] + lb[c1];
        VT[(d0 + j) * 136 + qk] = (h16)v0;
        VT[(d0 + j + 8) * 136 + qk] = (h16)v1;
      }
    }
    __syncthreads();
    f32x4 acc[4];
#pragma unroll
    for (int dt = 0; dt < 4; ++dt) acc[dt] = (f32x4){0.f, 0.f, 0.f, 0.f};
#pragma unroll
    for (int ks = 0; ks < 4; ++ks) {
      h16x8 af = *(const h16x8*)(SW + ((size_t)g8 * 128 + wv * 16 + fr) * 128 + ks * 32 + fq * 8);
#pragma unroll
      for (int dt = 0; dt < 4; ++dt) {
        h16x8 bf = *(const h16x8*)(VT + (dt * 16 + fr) * 136 + ks * 32 + fq * 8);
        acc[dt] = __builtin_amdgcn_mfma_f32_16x16x32_f16(bf, af, acc[dt], 0, 0, 0);
      }
    }
    {
      const int pr = wv * 16 + fr;
      const float bias = bs[g8 * 128 + pr];
      const h16* up = Z + (size_t)(row0 + pr) * ZOW + OC_SGU + g8 * 64 + fq * 4;
      h16* cp = CP + (size_t)(row0 + pr) * 512 + g8 * 64 + fq * 4;
#pragma unroll
      for (int dt = 0; dt < 4; ++dt) {
        h16x4 u4 = *(const h16x4*)(up + dt * 16);
        h16x4 o;
#pragma unroll
        for (int j = 0; j < 4; ++j) o[j] = (h16)(geluf_((float)u4[j]) * (acc[dt][j] + bias));
        *(h16x4*)(cp + dt * 16) = o;
      }
    }
    __syncthreads();
  }
}

__device__ __forceinline__ void phase_scan(CP4& p, int l, char* smc) {
  for (int pr = blockIdx.x; pr < NB * 16; pr += gridDim.x) scan_pair(p, l, pr >> 4, pr & 15, smc);
}
__device__ __forceinline__ void phase_convsgu(CP4& p, int l, int g, char* smc) {
  const bool last = (l == DEPTH - 1);
  int nb = gridDim.x, bi = blockIdx.x;
  int nconv_lat = GB * 64, nconv = nconv_lat + (last ? 0 : GB * 8);
  for (int u = (bi + nb - 144 % nb) % nb; u < nconv; u += nb) {
    int rowbase, stride, Lc, p0;
    if (u < nconv_lat) {
      int bl = u >> 6, w = u & 63;
      if ((l & 1) == 0) { rowbase = bl * SEQ + (w >> 1) * 64; stride = 1; Lc = 64; p0 = (w & 1) * 32; }
      else { rowbase = bl * SEQ + w; stride = 64; Lc = 32; p0 = 0; }
    } else {
      int uu = u - nconv_lat, bl = uu >> 3, sg = uu & 7;
      rowbase = MLAT + bl * CTX; stride = 1; Lc = CTX; p0 = sg * 32;
    }
    conv_unit(p, l, g, rowbase, stride, Lc, p0, smc);
  }
  int nsgu = last ? MLAT / 128 : MG / 128;
  for (int u = nb - 1 - bi; u < nsgu; u += nb) sgu_unit(p, l, g, u * 128, smc);
}

__device__ __forceinline__ void phase_postscan(CP4& p, int l, char* smc) {
  const bool last = (l == DEPTH - 1);
  const h16* Z = (const h16*)(p.ws + OFF_ZR);
  const h16* Y = (const h16*)(p.ws + OFF_YH);
  const h16* GT = (const h16*)(p.ws + OFF_GUPT);
  h16* AP = (h16*)(p.ws + OFF_APRE);
  const float* sw = p.in[9] + (size_t)l * 3 * RC;
  float* SWR = (float*)smc;
  float* GNC = SWR + 9 * 1024;
  h16* SG = (h16*)(GNC + 3 * 1024);
  h16* G = SG + 32 * 136;
  const int tid = ltid(), lane = tid & 63, wv = tid >> 6, fr = lane & 15, fq = lane >> 4;
  __syncthreads();
  for (int e = tid; e < 9 * 1024; e += NTHREADS) { int st = e >> 10, col = e & 1023, sg = st / 3, tap = st % 3; SWR[e] = sw[tap * RC + sg * D + col]; }
  for (int e = tid; e < 1024; e += NTHREADS) { GNC[e] = p.in[18][l * D + e]; GNC[1024 + e] = p.in[19][l * D + e]; GNC[2048 + e] = p.in[17][l * D + e]; }
  float sg0[8], sg1[8], sg2[8];
  {
    int kc = (tid & 15) * 8;
#pragma unroll
    for (int j = 0; j < 8; ++j) { sg0[j] = sw[3328 + kc + j]; sg1[j] = sw[RC + 3328 + kc + j]; sg2[j] = sw[2 * RC + 3328 + kc + j]; }
  }
  const h16x8 zero8 = {0, 0, 0, 0, 0, 0, 0, 0};
  const int ntiles = MALL / 32;
  for (int u = blockIdx.x; u < ntiles; u += gridDim.x) {
    const int row0 = u * 32;
    if (last && (row0 % MG) >= MLAT) continue;
    __syncthreads();
    {
      int tok = tid >> 4, kc = (tid & 15) * 8;
      int r = row0 + tok, t, L; seqposG(r, t, L);
      const h16* zp = Z + (size_t)r * ZRW + 3328 + kc;
      h16x8 b = *(const h16x8*)zp;
      h16x8 a = (t > 0) ? *(const h16x8*)(zp - ZRW) : zero8;
      h16x8 c = (t < L - 1) ? *(const h16x8*)(zp + ZRW) : zero8;
      h16x8 o;
#pragma unroll
      for (int j = 0; j < 8; ++j) o[j] = (h16)sigmoidf_((float)a[j] * sg0[j] + (float)b[j] * sg1[j] + (float)c[j] * sg2[j]);
      *(h16x8*)(SG + tok * 136 + kc) = o;
    }
    __syncthreads();
    {
      h16x8 af[2][4];
#pragma unroll
      for (int m = 0; m < 2; ++m)
#pragma unroll
        for (int ks = 0; ks < 4; ++ks) af[m][ks] = *(const h16x8*)(SG + (m * 16 + fr) * 136 + ks * 32 + fq * 8);
#pragma unroll
      for (int nt = 0; nt < 8; ++nt) {
        f32x4 acc0 = {0.f, 0.f, 0.f, 0.f}, acc1 = {0.f, 0.f, 0.f, 0.f};
        const h16* bp = GT + (size_t)(wv * 128 + nt * 16 + fr) * 128 + fq * 8;
#pragma unroll
        for (int ks = 0; ks < 4; ++ks) {
          h16x8 bf = *(const h16x8*)(bp + ks * 32);
          acc0 = __builtin_amdgcn_mfma_f32_16x16x32_f16(af[0][ks], bf, acc0, 0, 0, 0);
          acc1 = __builtin_amdgcn_mfma_f32_16x16x32_f16(af[1][ks], bf, acc1, 0, 0, 0);
        }
#pragma unroll
        for (int rg = 0; rg < 4; ++rg) {
          G[(fq * 4 + rg) * 1024 + wv * 128 + nt * 16 + fr] = (h16)acc0[rg];
          G[(16 + fq * 4 + rg) * 1024 + wv * 128 + nt * 16 + fr] = (h16)acc1[rg];
        }
      }
    }
    __syncthreads();
#pragma unroll 1
    for (int it = 0; it < 8; ++it) {
      const int tok = (tid >> 7) + 4 * it, col = (tid & 127) * 8;
      const int r = row0 + tok; int t, L; seqposG(r, t, L);
      const bool hp = t > 0, hn = t < L - 1;
      const h16* zp = Z + (size_t)r * ZRW + col;
      h16x8 yf = *(const h16x8*)(Y + (size_t)r * D + col), yb = *(const h16x8*)(Y + ((size_t)MALL + r) * D + col);
      h16x8 z[3][3];
#pragma unroll
      for (int sg = 0; sg < 3; ++sg) {
        z[sg][1] = *(const h16x8*)(zp + sg * D);
        z[sg][0] = hp ? *(const h16x8*)(zp + sg * D - ZRW) : zero8;
        z[sg][2] = hn ? *(const h16x8*)(zp + sg * D + ZRW) : zero8;
      }
      float y[8], s = 0.f;
#pragma unroll
      for (int j = 0; j < 8; ++j) { y[j] = ((float)yf[j] + (float)yb[j]) * YUN; s += y[j]; }
      s += __shfl_xor(s, 1, 64); s += __shfl_xor(s, 2, 64); s += __shfl_xor(s, 4, 64);
      const float mean = s * (1.0f / 64);
      float s2 = 0.f;
#pragma unroll
      for (int j = 0; j < 8; ++j) { y[j] -= mean; s2 += y[j] * y[j]; }
      s2 += __shfl_xor(s2, 1, 64); s2 += __shfl_xor(s2, 2, 64); s2 += __shfl_xor(s2, 4, 64);
      const float rstd = rsqrtf(s2 * (1.0f / 64) + 64e-5f);
      float vv[8], bs = 0.f;
#pragma unroll
      for (int j = 0; j < 8; ++j) {
        float rr = (float)z[0][0][j] * SWR[0 * 1024 + col + j] + (float)z[0][1][j] * SWR[1 * 1024 + col + j] + (float)z[0][2][j] * SWR[2 * 1024 + col + j];
        float kk = (float)z[1][0][j] * SWR[3 * 1024 + col + j] + (float)z[1][1][j] * SWR[4 * 1024 + col + j] + (float)z[1][2][j] * SWR[5 * 1024 + col + j];
        vv[j] = (float)z[2][0][j] * SWR[6 * 1024 + col + j] + (float)z[2][1][j] * SWR[7 * 1024 + col + j] + (float)z[2][2][j] * SWR[8 * 1024 + col + j];
        bs += rr * kk * GNC[2048 + col + j];
      }
      bs += __shfl_xor(bs, 1, 64); bs += __shfl_xor(bs, 2, 64); bs += __shfl_xor(bs, 4, 64);
      const h16x8 g8 = *(const h16x8*)(G + tok * 1024 + col);
      h16x8 o;
#pragma unroll
      for (int j = 0; j < 8; ++j) {
        float yn = y[j] * rstd * GNC[col + j] + GNC[1024 + col + j];
        o[j] = (h16)((yn + bs * vv[j]) * (float)g8[j]);
      }
      *(h16x8*)(AP + (size_t)r * D + col) = o;
    }
  }
}

constexpr int NLS = 5, NST = 6, NLE = 3;
constexpr int NPL = NLS + NG * NST + NLE;
constexpr int NPHASE = 2 + DEPTH * NPL + 1;

__device__ __forceinline__ void decode_phase(int ph, int& kind, int& l, int& g, int& st) {
  l = g = st = 0;
  if (ph == 0) { kind = 0; return; }
  if (ph == 1) { kind = 1; return; }
  if (ph == NPHASE - 1) { kind = 2; return; }
  int q = ph - 2; l = q / NPL; int s = q % NPL;
  if (s < NLS) { kind = 3; st = s; return; }
  s -= NLS;
  if (s < NG * NST) { kind = 4; g = s / NST; st = s % NST; return; }
  kind = 3; st = NLS + (s - NG * NST);
}
__device__ __forceinline__ bool step_needs_sync(int kind, int l, int g, int st) {
  if (kind == 3 && st == 0 && l > 0) return false;
  if (kind != 4) return true;
  if (st == 0) return g == 0;
  return st == 2 || st == 4 || st == 5;
}

__device__ __forceinline__ void run_nongemm(CP4& p, int kind, int l, int g, int st, char* smc) {
  if (kind == 0) phase_mod(p, (float*)smc);
  else if (kind == 1) phase_copyx(p);
  else if (kind == 2) phase_final(p);
  else if (kind == 3) {
    if (st == 1) phase_norm(p, l, 0);
    else if (st == 3) phase_scan(p, l, smc);
    else if (st == 4) phase_postscan(p, l, smc);
    else if (st == 5) phase_norm(p, l, 1);
  } else {
    if (st == 1) phase_convsgu(p, l, g, smc);
  }
}

__device__ __forceinline__ int opq(int x) { asm volatile("" : "+v"(x)); return __builtin_amdgcn_readfirstlane(x); }
__device__ __forceinline__ size_t opq64(size_t x) { int lo = opq((int)(unsigned)x), hi = opq((int)(unsigned)(x >> 32)); return ((size_t)(unsigned)hi << 32) | (unsigned)lo; }
struct GemmDesc { size_t offA, offB, offO, offZ; int K, nM, nN, mode, goff, ldo, ubeg, uend, brot, nblk, valid; };
__device__ __forceinline__ GemmDesc gemm_desc(int kind, int l, int g, int st, int j) {
  const bool last = (l == DEPTH - 1);
  const int nMr = (last ? MLAT : MG) / BM;
  const int grid = gridDim.x;
  GemmDesc d{};
  d.brot = 0; d.nblk = grid; d.valid = 0; d.offZ = OFF_ZO + (size_t)(g & 1) * ZO_BYTES;
  if (kind == 3) {
    if (j != 0) return d;
    d.valid = 1;
    if (st == 2) { d.offA = OFF_HALL; d.offB = OFF_WINT; d.offO = OFF_ZR; d.K = D; d.nM = MALL / BM; d.nN = ZRW / BM; d.mode = 0; d.ldo = ZRW; }
    else if (st == 6) { d.offA = OFF_HALL; d.offB = OFF_FFNINT; d.offO = OFF_HID; d.K = D; d.nM = MALL / BM; d.nN = 2 * DFF / BM; d.mode = 5; d.ldo = DFF; }
    else if (st == 7) { d.offA = OFF_HID; d.offB = (l & 1) ? OFF_FFNOUTT2 : OFF_FFNOUTT; d.offO = OFF_HID; d.K = DFF; d.nM = MALL / BM; d.nN = D / BM; d.mode = 4; d.goff = 5120; d.ldo = D; }
    else d.valid = 0;
    d.ubeg = 0; d.uend = d.nM * d.nN;
    return d;
  }
  if (kind != 4) return d;
  const bool shadow = (j > 0);
  const int gz = shadow ? g + 1 : g;
  if ((st == 0 && j == 0 && g == 0) || (shadow && gz < NG && ((st == 4 && j == 1) || (st == 5)))) {
    d.valid = 1;
    d.offA = OFF_HALL + (size_t)gz * MG * D * 2; d.offB = OFF_WINT + (size_t)ZRW * D * 2; d.offO = OFF_ZO + (size_t)(gz & 1) * ZO_BYTES;
    d.K = D; d.nM = nMr; d.nN = ZOW / BM; d.mode = 0; d.ldo = ZOW;
    const int tot = d.nM * d.nN;
    d.ubeg = 0; d.uend = tot;
    if (shadow) {
      const int nsh = grid > 144 ? grid - 144 : 0;
      const int nA = min(3 * nsh, tot), nB1 = min(nA + 2 * nsh, tot);
      if (st == 4) { d.ubeg = 0; d.uend = nA; d.brot = 144; d.nblk = nsh; }
      else if (j == 1) { d.ubeg = nA; d.uend = nB1; d.brot = 144; d.nblk = nsh; }
      else { d.ubeg = nB1; d.uend = tot; d.brot = 0; d.nblk = grid; }
      if (d.ubeg >= d.uend) d.valid = 0;
    }
    return d;
  }
  if (j != 0) return d;
  d.valid = 1; d.nM = nMr; d.nN = D / BM; d.ldo = D; d.offO = OFF_M16;
  if (st == 2) { d.offA = OFF_APRE + (size_t)g * MG * D * 2; d.offB = OFF_ROUTT; d.K = 1024; d.mode = 1; }
  else if (st == 3) { d.offA = OFF_BPRE; d.offB = OFF_COUTT; d.K = 512; d.mode = 2; }
  else if (st == 4) { d.offA = OFF_CPRE; d.offB = OFF_SOUTT; d.K = 512; d.mode = 3; }
  else if (st == 5) { d.offA = OFF_M16; d.offB = OFF_WMT; d.K = D; d.mode = 4; d.goff = 2048; }
  else d.valid = 0;
  d.ubeg = 0; d.uend = d.nM * d.nN;
  return d;
}

__global__ void __launch_bounds__(NTHREADS) mk(P p, int ph0, int ph1, int coop) {
  extern __shared__ __attribute__((aligned(16))) char smc[];
  cg::grid_group grid = cg::this_grid();
  CP4* pp = (CP4*)__builtin_amdgcn_kernarg_segment_ptr();
  unsigned nbar = 0;
#pragma nounroll
  for (int ph = ph0; ph < ph1; ++ph) {
    CP4* q = pp;
    asm volatile("" : "+s"(q));
    int kind, l, g, st; decode_phase(ph, kind, l, g, st);
    run_nongemm(*q, kind, l, g, st, smc);
#pragma nounroll
    for (int j = 0; j < 3; ++j) {
      GemmDesc d = gemm_desc(kind, l, g, st, j);
      d.offA = opq64(d.offA); d.offB = opq64(d.offB); d.offO = opq64(d.offO); d.offZ = opq64(d.offZ);
      d.K = opq(d.K); d.nM = opq(d.nM); d.nN = opq(d.nN); d.mode = opq(d.mode); d.goff = opq(d.goff); d.ldo = opq(d.ldo);
      d.ubeg = opq(d.ubeg); d.uend = opq(d.uend); d.brot = opq(d.brot); d.nblk = opq(d.nblk); d.valid = opq(d.valid);
      if (!d.valid) continue;
      char* ws = q->ws;
      EpiAny e{d.mode, (h16*)(ws + d.offO), (const h16*)(ws + d.offZ), nullptr, q->out, ws, l, (kind == 3 ? 0 : g), d.goff, d.ldo};
      gemm_phase((LAS unsigned char*)smc, (const h16*)(ws + d.offA), (const h16*)(ws + d.offB), d.K, 0, d.nM, d.nN, d.ubeg, d.uend, d.brot, d.nblk, e);
    }
    {
      int cl = -1, cb0 = 0;
      if (kind == 3 && st == 0 && l == 0) cl = 0;
      if (kind == 3 && st == 7 && l + 1 < DEPTH) { cl = l + 1; cb0 = (gridDim.x > 128) ? 64 : 0; }
      if (cl >= 0) phase_convert(*q, cl, (float*)smc, cb0, (int)gridDim.x - cb0);
    }
    if (coop && ph + 1 < ph1 && step_needs_sync(kind, l, g, st) && ph >= 2) {
      if (ph == 2) grid.sync();
      else { ++nbar; grid_bar((unsigned*)(q->ws + OFF_BAR), nbar * gridDim.x); }
    }
  }
}

extern "C" void kernel_launch(void* const* d_in, const int* in_sizes, int n_in, void* d_out, int out_size, void* d_ws, size_t ws_size,
                              hipStream_t stream) {
  if (ws_size < WS_TOTAL) return;
  P p{};
  for (int i = 0; i < 35; ++i) p.in[i] = (const float*)d_in[i];
  p.out = (float*)d_out;
  p.ws = (char*)d_ws;
  static bool attr = false;
  if (!attr) { (void)hipFuncSetAttribute((const void*)mk, hipFuncAttributeMaxDynamicSharedMemorySize, SHM_BYTES); attr = true; }
#if COOP
  static int grid_blocks = 0;
  if (!grid_blocks) {
    int dev = 0, cus = 0, per_cu = 0;
    (void)hipGetDevice(&dev);
    (void)hipDeviceGetAttribute(&cus, hipDeviceAttributeMultiprocessorCount, dev);
    (void)hipOccupancyMaxActiveBlocksPerMultiprocessor(&per_cu, mk, NTHREADS, SHM_BYTES);
    grid_blocks = cus;
  }
  (void)hipMemsetAsync((char*)d_ws + OFF_BAR, 0, 256, stream);
  int ph0 = 0, ph1 = NPHASE, coop = 1;
  void* args[] = {&p, &ph0, &ph1, &coop};
  (void)hipLaunchCooperativeKernel((void*)mk, dim3(grid_blocks), dim3(NTHREADS), args, SHM_BYTES, stream);
#else
  for (int ph = 0; ph < NPHASE; ++ph) mk<<<256, NTHREADS, SHM_BYTES, stream>>>(p, ph, ph + 1, 0);
#endif
}
```

```cpp
#include <hip/hip_runtime.h>
#include <hip/hip_cooperative_groups.h>
namespace cg = cooperative_groups;

#ifndef REP_SCAN
#define REP_SCAN 1
#endif
#ifndef REP_POST
#define REP_POST 1
#endif
#ifndef REP_CS
#define REP_CS 1
#endif
#ifndef REP_ZR
#define REP_ZR 1
#endif
#ifndef COOP
#define COOP 1
#endif

typedef _Float16 h16;
typedef _Float16 h16x8 __attribute__((ext_vector_type(8)));
typedef _Float16 h16x4 __attribute__((ext_vector_type(4)));
typedef float f32x4 __attribute__((ext_vector_type(4)));
typedef float f32x2 __attribute__((ext_vector_type(2)));

constexpr int D = 1024, NB = 16, SEQ = 2048, DEPTH = 4, CTX = 256;
constexpr int PIN = 8576, PINP = 8704, RC = 3456;
constexpr int ZRW = 3584;
constexpr int ZOW = 5120;
constexpr int OC_CONV = 0, OC_SGU = 1024, OC_GATE = 2048;
constexpr int DFF = 2816;
constexpr int GB = 4, NG = NB / GB;
constexpr int MLAT = GB * SEQ, MCTX = GB * CTX, MG = MLAT + MCTX;
constexpr int NLAT = NB * SEQ, MALL = NB * (SEQ + CTX);
constexpr int NTHREADS = 512;
constexpr int SHM_BYTES = 131072;
constexpr float YSC = 0.0625f, YUN = 16.0f;

constexpr size_t al256(size_t x) { return (x + 255) / 256 * 256; }
constexpr size_t OFF_MOD = 0;
constexpr size_t OFF_BAR = al256(OFF_MOD + (size_t)4 * 17 * 6144 * 4);
constexpr size_t OFF_CTXX = al256(OFF_BAR + 256);
constexpr size_t OFF_WINT = al256(OFF_CTXX + (size_t)NB * CTX * D * 4);
constexpr size_t OFF_FFNINT = al256(OFF_WINT + (size_t)PINP * D * 2);
constexpr size_t OFF_FFNOUTT = al256(OFF_FFNINT + (size_t)2 * DFF * D * 2);
constexpr size_t OFF_ROUTT = al256(OFF_FFNOUTT + (size_t)D * DFF * 2);
constexpr size_t OFF_WMT = al256(OFF_ROUTT + (size_t)D * D * 2);
constexpr size_t OFF_COUTT = al256(OFF_WMT + (size_t)D * D * 2);
constexpr size_t OFF_SOUTT = al256(OFF_COUTT + (size_t)D * 512 * 2);
constexpr size_t OFF_SGUW = al256(OFF_SOUTT + (size_t)D * 512 * 2);
constexpr size_t OFF_GUPT = al256(OFF_SGUW + (size_t)8 * 128 * 128 * 2);
constexpr size_t OFF_HALL = al256(OFF_GUPT + (size_t)D * 128 * 2);
constexpr size_t OFF_YH = al256(OFF_HALL + (size_t)MALL * D * 2);
constexpr size_t OFF_APRE = OFF_YH;
constexpr size_t OFF_ZR = al256(OFF_YH + (size_t)2 * MALL * D * 2);
constexpr size_t OFF_FFNOUTT2 = al256(OFF_ZR + (size_t)MALL * ZRW * 2);
constexpr size_t WS_TOTAL = al256(OFF_FFNOUTT2 + (size_t)D * DFF * 2);
constexpr size_t ZO_BYTES = (size_t)MG * ZOW * 2;
constexpr size_t OFF_ZO = OFF_ZR;
constexpr size_t OFF_BPRE = al256(OFF_ZO + 2 * ZO_BYTES);
constexpr size_t OFF_CPRE = al256(OFF_BPRE + (size_t)MG * 512 * 2);
constexpr size_t OFF_M16 = al256(OFF_CPRE + (size_t)MG * 512 * 2);
constexpr size_t OFF_HID = OFF_ZR;
static_assert(OFF_M16 + (size_t)MG * D * 2 <= OFF_FFNOUTT2, "group buffers must fit in the ZR region");
static_assert(OFF_HID + (size_t)MALL * DFF * 2 <= OFF_FFNOUTT2, "ffn hidden must fit in the ZR region");

struct P {
  const float* in[35];
  float* out;
  char* ws;
};
typedef const __attribute__((address_space(4))) P CP4;

__device__ __forceinline__ float wave_sum(float v) {
#pragma unroll
  for (int m = 32; m >= 1; m >>= 1) v += __shfl_xor(v, m, 64);
  return v;
}
__device__ __forceinline__ int ltid() { int t = threadIdx.x; asm volatile("" : "+v"(t)); return t; }
__device__ __forceinline__ float sigmoidf_(float x) { return __builtin_amdgcn_rcpf(1.0f + __expf(-x)); }
__device__ __forceinline__ float siluf_(float x) { return x * sigmoidf_(x); }
__device__ __forceinline__ float tanhf_(float x) { return 1.0f - 2.0f * __builtin_amdgcn_rcpf(1.0f + __expf(2.0f * x)); }
__device__ __forceinline__ float geluf_(float x) {
  float u = 0.7978845608028654f * (x + 0.044715f * x * x * x);
  return x * __builtin_amdgcn_rcpf(1.0f + __expf(-2.0f * u));
}
__device__ __forceinline__ float* xrow2(float* out, char* ws, int g, int r) {
  return (r < MLAT) ? out + ((size_t)g * MLAT + r) * D
                    : (float*)(ws + OFF_CTXX) + ((size_t)g * MCTX + (r - MLAT)) * D;
}
__device__ __forceinline__ const float* modrow2(const char* ws, int l, int g, int r) {
  int i = (r < MLAT) ? (g * GB + r / SEQ) : 16;
  return (const float*)(ws + OFF_MOD) + ((size_t)l * 17 + i) * 6144;
}
__device__ __forceinline__ float* xrow(CP4& p, int g, int r) { return xrow2(p.out, p.ws, g, r); }
__device__ __forceinline__ const float* modrow(CP4& p, int l, int g, int r) { return modrow2(p.ws, l, g, r); }
__device__ __forceinline__ void seqposG(int R, int& t, int& L) {
  int lr = R % MG;
  if (lr < MLAT) { t = lr % SEQ; L = SEQ; } else { t = (lr - MLAT) % CTX; L = CTX; }
}
__device__ __forceinline__ float zshift(const h16* Z, const float* sw, int r, int t, int L, int col) {
  float v = (float)Z[(size_t)r * ZRW + col] * sw[RC + col];
  if (t > 0) v += (float)Z[(size_t)(r - 1) * ZRW + col] * sw[col];
  if (t < L - 1) v += (float)Z[(size_t)(r + 1) * ZRW + col] * sw[2 * RC + col];
  return v;
}
__device__ __forceinline__ void grid_bar(unsigned* ctr, unsigned target) {
  asm volatile("s_waitcnt vmcnt(0) lgkmcnt(0)" ::: "memory");
  __syncthreads();
  if (threadIdx.x == 0) {
    __builtin_amdgcn_fence(__ATOMIC_RELEASE, "agent");
    asm volatile("s_waitcnt vmcnt(0)" ::: "memory");
    __hip_atomic_fetch_add(ctr, 1u, __ATOMIC_RELAXED, __HIP_MEMORY_SCOPE_AGENT);
    while (__hip_atomic_load(ctr, __ATOMIC_RELAXED, __HIP_MEMORY_SCOPE_AGENT) < target) __builtin_amdgcn_s_sleep(1);
    __builtin_amdgcn_fence(__ATOMIC_ACQUIRE, "agent");
    asm volatile("s_waitcnt vmcnt(0)" ::: "memory");
  }
  __syncthreads();
}

#define LAS __attribute__((address_space(3)))
constexpr int BM = 256, BK = 64, HALF = 128, HTB = HALF * BK * 2;
__device__ __forceinline__ int lds_byte(int r, int c) {
  int st = (r >> 4) * 2 + (c >> 5), rr = r & 15, cc = c & 31, ob = rr * 64 + cc * 2;
  return st * 1024 + (ob ^ (((ob >> 9) & 1) << 5));
}
__device__ __forceinline__ void stage_rc(int b, int& R, int& C) {
  int st = b / 1024, sb = b % 1024, swz = sb ^ (((sb >> 9) & 1) << 5);
  R = (st >> 1) * 16 + swz / 64; C = (st & 1) * 32 + (swz % 64) / 2;
}
__device__ __forceinline__ bool tile_of(int i, int nM, int nN, int ubeg, int uend, int brot, int nblk, int& pm, int& pn) {
  const int NXCD = 8, WGM = 8;
  int nwg = nM * nN;
  int bsub = (int)blockIdx.x - brot; if (bsub < 0) bsub += gridDim.x;
  if (bsub >= nblk) return false;
  long Lq = (long)ubeg + (long)i * nblk + bsub; if (Lq >= uend) return false;
  int wgid = (int)Lq;
  { int q = nwg / NXCD, r = nwg % NXCD, xcd = wgid % NXCD, off = wgid / NXCD;
    wgid = (xcd < r ? xcd * (q + 1) : r * (q + 1) + (xcd - r) * q) + off; }
  int nig = WGM * nN, gid = wgid / nig, fm = gid * WGM, gsz = min(nM - fm, WGM);
  pm = fm + ((wgid % nig) % gsz); pn = (wgid % nig) / gsz;
  return true;
}

template <class Epi>
__device__ __forceinline__ void gemm_phase(LAS unsigned char* lds, const h16* Ag, const h16* Btg, int K, int row0, int nM, int nN, int ubeg, int uend, int brot, int nblk, const Epi& E) {
  const int tid = threadIdx.x, wid = __builtin_amdgcn_readfirstlane(tid >> 6), lane = tid & 63, wr = wid >> 2, wc = wid & 3, fr = lane & 15, fq = lane >> 4;
  const int nt = K / BK;
  unsigned voffA[2];
#pragma unroll
  for (int i = 0; i < 2; ++i) { int R, C; stage_rc(tid * 16 + i * 8192, R, C); voffA[i] = (unsigned)(R * K + C) * 2u; }
  const size_t kstep = (size_t)(BK * 2);
  const size_t hstep = (size_t)HALF * K * 2;
  const size_t tstep = 2 * hstep;
  const unsigned ldsw = (unsigned)wid * 1024u;
  const int aoff = lds_byte(wr * 64 + fr, fq * 8), boff = lds_byte(wc * 32 + fr, fq * 8);
  const char* Abase = (const char*)(Ag + (size_t)row0 * K);
#define PG8_SA(b, h) (((b) * 2 + (h)) * HTB)
#define PG8_SB(b, h) ((4 + (b) * 2 + (h)) * HTB)
#define PG8_STAGE(bufoff, gbase, voff) do { _Pragma("unroll") for (int _i = 0; _i < 2; ++_i) \
    __builtin_amdgcn_global_load_lds((const unsigned*)((const char*)(gbase) + (voff)[_i]), (LAS unsigned*)(lds + (bufoff) + ldsw + _i * 8192), 16, 0, 0); } while (0)
#define PG8_LDA(dst, b, h) do { _Pragma("unroll") for (int m = 0; m < 4; ++m) _Pragma("unroll") for (int k = 0; k < 2; ++k) dst[m][k] = *(const LAS h16x8*)(lds + PG8_SA(b, h) + aoff + m * 2048 + k * 1024); } while (0)
#define PG8_LDB(dst, b, h) do { _Pragma("unroll") for (int n = 0; n < 2; ++n) _Pragma("unroll") for (int k = 0; k < 2; ++k) dst[n][k] = *(const LAS h16x8*)(lds + PG8_SB(b, h) + boff + n * 2048 + k * 1024); } while (0)
#define PG8_MMA(ai, bj, At, Bt) do { __builtin_amdgcn_s_setprio(1); _Pragma("unroll") for (int m = 0; m < 4; ++m) _Pragma("unroll") for (int n = 0; n < 2; ++n) _Pragma("unroll") for (int k = 0; k < 2; ++k) \
    acc[ai][bj][m][n] = __builtin_amdgcn_mfma_f32_16x16x32_f16(Bt[n][k], At[m][k], acc[ai][bj][m][n], 0, 0, 0); __builtin_amdgcn_s_setprio(0); } while (0)
#define PG8_WAIT_V(n) asm volatile("s_waitcnt vmcnt(" #n ")" ::: "memory")
#define PG8_WAIT_L(n) asm volatile("s_waitcnt lgkmcnt(" #n ")" ::: "memory")
#define PG8_BAR __builtin_amdgcn_s_barrier()
#define PG8_SCHED __builtin_amdgcn_sched_barrier(0)
  int cpm, cpn, npm, npn, ui = 0;
  __syncthreads();
  if (!tile_of(0, nM, nN, ubeg, uend, brot, nblk, cpm, cpn)) return;
  f32x4 acc[2][2][4][2];
#pragma unroll
  for (int a = 0; a < 2; ++a)
#pragma unroll
    for (int b = 0; b < 2; ++b)
#pragma unroll
      for (int m = 0; m < 4; ++m)
#pragma unroll
        for (int n = 0; n < 2; ++n) acc[a][b][m][n] = (f32x4){0.f, 0.f, 0.f, 0.f};
  h16x8 At[4][2], B0[2][2], B1[2][2];
  const char* cA = Abase + (size_t)cpm * tstep; const char* cB = (const char*)Btg + (size_t)cpn * tstep;
  PG8_STAGE(PG8_SB(0, 0), cB, voffA); PG8_STAGE(PG8_SA(0, 0), cA, voffA); PG8_STAGE(PG8_SB(0, 1), cB + hstep, voffA); PG8_STAGE(PG8_SA(0, 1), cA + hstep, voffA);
  if (wr == 1) PG8_BAR;
  PG8_WAIT_V(4); PG8_BAR;
  PG8_STAGE(PG8_SB(1, 0), cB + kstep, voffA); PG8_STAGE(PG8_SA(1, 0), cA + kstep, voffA); PG8_STAGE(PG8_SB(1, 1), cB + hstep + kstep, voffA);
  PG8_WAIT_V(6); PG8_BAR;
  for (;;) {
    const bool has_next = tile_of(ui + 1, nM, nN, ubeg, uend, brot, nblk, npm, npn);
    const char* nA = has_next ? Abase + (size_t)npm * tstep : cA; const char* nB = has_next ? (const char*)Btg + (size_t)npn * tstep : cB;
    for (int t = 0; t < nt; t += 2) {
      const bool last = (t == nt - 2);
      const char* a1 = cA + (size_t)(t + 1) * kstep;
      const char* a2 = last ? nA : cA + (size_t)(t + 2) * kstep; const char* b2 = last ? nB : cB + (size_t)(t + 2) * kstep;
      const char* a3 = a2 + kstep; const char* b3 = b2 + kstep;
      PG8_LDB(B0, 0, 0); PG8_SCHED; PG8_LDA(At, 0, 0); PG8_STAGE(PG8_SA(1, 1), a1 + hstep, voffA);
      PG8_WAIT_L(8); PG8_BAR; PG8_WAIT_L(0); PG8_MMA(0, 0, At, B0); PG8_BAR; PG8_SCHED;
      PG8_LDB(B1, 0, 1); PG8_STAGE(PG8_SB(0, 0), b2, voffA);
      PG8_BAR; PG8_WAIT_L(0); PG8_MMA(0, 1, At, B1); PG8_BAR;
      PG8_LDA(At, 0, 1); PG8_STAGE(PG8_SA(0, 0), a2, voffA);
      PG8_BAR; PG8_WAIT_L(0); PG8_MMA(1, 0, At, B0); PG8_BAR; PG8_SCHED;
      PG8_STAGE(PG8_SB(0, 1), b2 + hstep, voffA);
      PG8_WAIT_V(6); PG8_BAR; PG8_MMA(1, 1, At, B1); PG8_BAR;
      PG8_LDB(B0, 1, 0); PG8_SCHED; PG8_LDA(At, 1, 0); PG8_STAGE(PG8_SA(0, 1), a2 + hstep, voffA);
      PG8_WAIT_L(8); PG8_BAR; PG8_WAIT_L(0); PG8_MMA(0, 0, At, B0); PG8_BAR; PG8_SCHED;
      PG8_LDB(B1, 1, 1); PG8_STAGE(PG8_SB(1, 0), b3, voffA);
      PG8_BAR; PG8_WAIT_L(0); PG8_MMA(0, 1, At, B1); PG8_BAR;
      PG8_LDA(At, 1, 1); PG8_STAGE(PG8_SA(1, 0), a3, voffA);
      PG8_BAR; PG8_WAIT_L(0); PG8_MMA(1, 0, At, B0); PG8_BAR; PG8_SCHED;
      PG8_STAGE(PG8_SB(1, 1), b3 + hstep, voffA);
      PG8_WAIT_V(6); PG8_BAR; PG8_MMA(1, 1, At, B1); PG8_BAR;
    }
    E(acc, row0 + cpm * BM, cpn * BM, wr, wc, fr, fq);
    if (!has_next) break;
#pragma unroll
    for (int a = 0; a < 2; ++a)
#pragma unroll
      for (int b = 0; b < 2; ++b)
#pragma unroll
        for (int m = 0; m < 4; ++m)
#pragma unroll
          for (int n = 0; n < 2; ++n) acc[a][b][m][n] = (f32x4){0.f, 0.f, 0.f, 0.f};
    cpm = npm; cpn = npn; cA = nA; cB = nB; ++ui;
  }
  PG8_WAIT_V(0);
  if (wr == 0) PG8_BAR;
  PG8_BAR;
#undef PG8_SA
#undef PG8_SB
#undef PG8_STAGE
#undef PG8_LDA
#undef PG8_LDB
#undef PG8_MMA
}

struct EpiAny {
  int mode; h16* O16; const h16* Z; float* MT; float* out; char* ws; int l, g, goff, ldo;
  __device__ __forceinline__ void operator()(const f32x4 (&acc)[2][2][4][2], int brow, int bcol, int wr, int wc, int fr, int fq) const {
    if (mode == 0) {
#pragma unroll
      for (int ai = 0; ai < 2; ++ai)
#pragma unroll
        for (int m = 0; m < 4; ++m) {
          int row = brow + ai * 128 + wr * 64 + m * 16 + fr;
#pragma unroll
          for (int bj = 0; bj < 2; ++bj) {
            int col = bcol + bj * 128 + wc * 32 + fq * 8;
            f32x4 a = acc[ai][bj][m][0], b = acc[ai][bj][m][1];
            h16x8 o = {(h16)a[0], (h16)a[1], (h16)a[2], (h16)a[3], (h16)b[0], (h16)b[1], (h16)b[2], (h16)b[3]};
            *(h16x8*)(O16 + (size_t)row * ldo + col) = o;
          }
        }
    } else if (mode <= 3) {
      const int bm = mode - 1;
#pragma unroll
      for (int ai = 0; ai < 2; ++ai) {
        h16x8 gts[4][2], old[4][2];
#pragma unroll
        for (int m = 0; m < 4; ++m) {
          int row = brow + ai * 128 + wr * 64 + m * 16 + fr;
#pragma unroll
          for (int bj = 0; bj < 2; ++bj) {
            int col = bcol + bj * 128 + wc * 32 + fq * 8;
            gts[m][bj] = *(const h16x8*)(Z + (size_t)row * ZOW + OC_GATE + bm * D + col);
            if (bm != 0) old[m][bj] = *(const h16x8*)(O16 + (size_t)row * D + col);
          }
        }
#pragma unroll
        for (int m = 0; m < 4; ++m) {
          int row = brow + ai * 128 + wr * 64 + m * 16 + fr;
#pragma unroll
          for (int bj = 0; bj < 2; ++bj) {
            int col = bcol + bj * 128 + wc * 32 + fq * 8;
            const h16x8 gt = gts[m][bj];
            f32x4 a = acc[ai][bj][m][0], b = acc[ai][bj][m][1];
            float v[8];
#pragma unroll
            for (int j = 0; j < 4; ++j) { v[j] = a[j] * sigmoidf_((float)gt[j]); v[4 + j] = b[j] * sigmoidf_((float)gt[4 + j]); }
            if (bm != 0) {
#pragma unroll
              for (int j = 0; j < 8; ++j) v[j] += (float)old[m][bj][j]; }
            h16x8 hv;
#pragma unroll
            for (int j = 0; j < 8; ++j) hv[j] = (h16)v[j];
            *(h16x8*)(O16 + (size_t)row * D + col) = hv;
          }
        }
      }
    } else if (mode == 4) {
      f32x4 gt[2][2];
      {
        const int gg0 = g + brow / MG, lr0 = brow % MG;
        const float* md = modrow2(ws, l, gg0, lr0) + goff;
#pragma unroll
        for (int bj = 0; bj < 2; ++bj)
#pragma unroll
          for (int n = 0; n < 2; ++n) gt[bj][n] = *(const f32x4*)(md + bcol + bj * 128 + wc * 32 + n * 16 + fq * 4);
      }
#pragma unroll
      for (int ai = 0; ai < 2; ++ai) {
        f32x4 o[4][2][2]; float* xrs[4];
#pragma unroll
        for (int m = 0; m < 4; ++m) {
          int row = brow + ai * 128 + wr * 64 + m * 16 + fr;
          const int gg = g + row / MG, lr = row % MG;
          float* xr = xrow2(out, ws, gg, lr);
          xrs[m] = xr;
#pragma unroll
          for (int bj = 0; bj < 2; ++bj)
#pragma unroll
            for (int n = 0; n < 2; ++n) o[m][bj][n] = *(const f32x4*)(xr + bcol + bj * 128 + wc * 32 + n * 16 + fq * 4);
        }
#pragma unroll
        for (int m = 0; m < 4; ++m)
#pragma unroll
          for (int bj = 0; bj < 2; ++bj)
#pragma unroll
            for (int n = 0; n < 2; ++n)
              *(f32x4*)(xrs[m] + bcol + bj * 128 + wc * 32 + n * 16 + fq * 4) = o[m][bj][n] + gt[bj][n] * acc[ai][bj][m][n];
      }
    } else {
      int hb = (bcol >> 8) * 128;
#pragma unroll
      for (int ai = 0; ai < 2; ++ai)
#pragma unroll
        for (int m = 0; m < 4; ++m) {
          int row = brow + ai * 128 + wr * 64 + m * 16 + fr;
          int col = hb + wc * 32 + fq * 8;
          h16x8 o;
#pragma unroll
          for (int n = 0; n < 2; ++n) {
            f32x4 a = acc[ai][0][m][n], b = acc[ai][1][m][n];
#pragma unroll
            for (int j = 0; j < 4; ++j) o[n * 4 + j] = (h16)(siluf_(a[j]) * b[j]);
          }
          *(h16x8*)(O16 + (size_t)row * DFF + col) = o;
        }
    }
  }
};

__device__ __forceinline__ void phase_mod(CP4& p, float* sm) {
  float* SC = sm;
  float* RED = sm + 17 * 1024;
  int tid = ltid();
  for (int u = blockIdx.x; u < 4 * 48; u += gridDim.x) {
    int l = u / 48, cb = (u % 48) * 128;
    __syncthreads();
    for (int e = tid; e < 17 * 1024; e += NTHREADS) {
      int i = e >> 10, k = e & 1023;
      float c = (i < 16) ? p.in[1][i * 1024 + k] : p.in[3][k];
      SC[e] = siluf_(c);
    }
    __syncthreads();
    int cj = tid & 127, kq = tid >> 7;
    const float* W = p.in[4] + (size_t)l * 1024 * 6144 + cb + cj;
    float acc[17];
#pragma unroll
    for (int i = 0; i < 17; ++i) acc[i] = 0.f;
    for (int k = kq * 256; k < kq * 256 + 256; k += 4) {
      float w0 = W[(size_t)k * 6144], w1 = W[(size_t)(k + 1) * 6144], w2 = W[(size_t)(k + 2) * 6144], w3 = W[(size_t)(k + 3) * 6144];
#pragma unroll
      for (int i = 0; i < 17; ++i) {
        float4 s = *(const float4*)(SC + i * 1024 + k);
        acc[i] += s.x * w0 + s.y * w1 + s.z * w2 + s.w * w3;
      }
    }
#pragma unroll
    for (int i = 0; i < 17; ++i) RED[(kq * 17 + i) * 128 + cj] = acc[i];
    __syncthreads();
    if (kq == 0) {
      float* MO = (float*)(p.ws + OFF_MOD);
      float b = p.in[5][l * 6144 + cb + cj];
#pragma unroll
      for (int i = 0; i < 17; ++i) {
        float v = RED[(0 * 17 + i) * 128 + cj] + RED[(1 * 17 + i) * 128 + cj] + RED[(2 * 17 + i) * 128 + cj] + RED[(3 * 17 + i) * 128 + cj];
        MO[((size_t)l * 17 + i) * 6144 + cb + cj] = v + b;
      }
    }
  }
}

__device__ __forceinline__ void phase_copyx(CP4& p) {
  size_t n1 = (size_t)NB * SEQ * D / 4, n2 = (size_t)NB * CTX * D / 4;
  const float4* s1 = (const float4*)p.in[0]; float4* d1 = (float4*)p.out;
  const float4* s2 = (const float4*)p.in[2]; float4* d2 = (float4*)(p.ws + OFF_CTXX);
  size_t stride = (size_t)gridDim.x * NTHREADS;
  for (size_t i = (size_t)blockIdx.x * NTHREADS + ltid(); i < n1; i += stride) d1[i] = s1[i];
  for (size_t i = (size_t)blockIdx.x * NTHREADS + ltid(); i < n2; i += stride) d2[i] = s2[i];
}

__device__ __forceinline__ int perm32(int rho) { const int n = rho >> 4, i = rho & 15; return 8 * (i >> 2) + 4 * n + (i & 3); }
__device__ __forceinline__ void tr_job(const float* src, int K, int Nsrc, h16* dst, int Ndst, int mode, bool perm, float* T, int b0, int nb) {
  int tk = K / 64, tn = Ndst / 64;
  int tid = ltid();
  if ((int)blockIdx.x < b0) return;
  const int lk = tid >> 4, lc = (tid & 15) * 4;
  const int sn = tid >> 3, sk = (tid & 7) * 8;
  const int ln = perm ? ((sn & 32) + perm32(sn & 31)) : sn;
  for (int u = blockIdx.x - b0; u < tk * tn; u += nb) {
    int k0 = (u % tk) * 64, n0 = (u / tk) * 64;
    int sn0;
    if (mode == 1) { int pn = n0 >> 8, j = n0 & 255; sn0 = (j < 128) ? pn * 128 + j : DFF + pn * 128 + (j - 128); }
    else if (mode == 2) sn0 = (n0 < RC) ? n0 : (n0 < ZRW ? Nsrc : n0 - (ZRW - RC));
    else sn0 = n0;
    bool valid = sn0 < Nsrc;
    f32x4 v0 = {0.f, 0.f, 0.f, 0.f}, v1 = {0.f, 0.f, 0.f, 0.f};
    if (valid) {
      v0 = *(const f32x4*)(src + (size_t)(k0 + lk) * Nsrc + sn0 + lc);
      v1 = *(const f32x4*)(src + (size_t)(k0 + lk + 32) * Nsrc + sn0 + lc);
    }
    __syncthreads();
    *(f32x4*)(T + lk * 68 + lc) = v0;
    *(f32x4*)(T + (lk + 32) * 68 + lc) = v1;
    __syncthreads();
    h16x8 o;
#pragma unroll
    for (int e = 0; e < 8; ++e) o[e] = (h16)T[(sk + e) * 68 + ln];
    *(h16x8*)(dst + (size_t)(n0 + sn) * K + k0 + sk) = o;
  }
}
__device__ __forceinline__ void phase_convert(CP4& p, int l, float* sm, int b0, int nb) {
  tr_job(p.in[8] + (size_t)l * D * PIN, D, PIN, (h16*)(p.ws + OFF_WINT), PINP, 2, true, sm, b0, nb);
  tr_job(p.in[32] + (size_t)l * D * 2 * DFF, D, 2 * DFF, (h16*)(p.ws + OFF_FFNINT), 2 * DFF, 1, true, sm, b0, nb);
  tr_job(p.in[33] + (size_t)l * DFF * D, DFF, D, (h16*)(p.ws + ((l & 1) ? OFF_FFNOUTT2 : OFF_FFNOUTT)), D, 0, false, sm, b0, nb);
  tr_job(p.in[20] + (size_t)l * D * D, D, D, (h16*)(p.ws + OFF_ROUTT), D, 0, true, sm, b0, nb);
  tr_job(p.in[31] + (size_t)l * D * D, D, D, (h16*)(p.ws + OFF_WMT), D, 0, false, sm, b0, nb);
  tr_job(p.in[25] + (size_t)l * 512 * D, 512, D, (h16*)(p.ws + OFF_COUTT), D, 0, true, sm, b0, nb);
  tr_job(p.in[30] + (size_t)l * 512 * D, 512, D, (h16*)(p.ws + OFF_SOUTT), D, 0, true, sm, b0, nb);
  tr_job(p.in[14] + (size_t)l * 128 * D, 128, D, (h16*)(p.ws + OFF_GUPT), D, 0, false, sm, b0, nb);
  if ((int)blockIdx.x < b0) return;
  const float* sw = p.in[28] + (size_t)l * 8 * 128 * 128;
  h16* dw = (h16*)(p.ws + OFF_SGUW);
  for (int i = (blockIdx.x - b0) * NTHREADS + ltid(); i < 8 * 128 * 128; i += nb * NTHREADS) dw[i] = (h16)sw[i];
}

__device__ __forceinline__ void phase_norm(CP4& p, int l, int which) {
  const float* gam = p.in[which ? 7 : 6] + l * D;
  h16* H = (h16*)(p.ws + OFF_HALL);
  int tid_ = ltid(); int lane = tid_ & 63, wv = tid_ >> 6;
  for (int r = blockIdx.x * 8 + wv; r < MALL; r += gridDim.x * 8) {
    int g = r / MG, lr = r % MG;
    const float* x = xrow(p, g, lr);
    const float* md = modrow(p, l, g, lr) + which * 3072;
    f32x4 v[4]; float ss = 0.f;
#pragma unroll
    for (int i = 0; i < 4; ++i) { v[i] = *(const f32x4*)(x + i * 256 + lane * 4); ss += v[i][0] * v[i][0] + v[i][1] * v[i][1] + v[i][2] * v[i][2] + v[i][3] * v[i][3]; }
    ss = wave_sum(ss);
    float rs = rsqrtf(ss * (1.0f / D) + 1e-6f);
#pragma unroll
    for (int i = 0; i < 4; ++i) {
      int c = i * 256 + lane * 4;
      f32x4 gm = *(const f32x4*)(gam + c), sh = *(const f32x4*)(md + c), sc = *(const f32x4*)(md + D + c);
      h16x4 o;
#pragma unroll
      for (int j = 0; j < 4; ++j) o[j] = (h16)((v[i][j] * rs * gm[j]) * (1.0f + sc[j]) + sh[j]);
      *(h16x4*)(H + (size_t)r * D + c) = o;
    }
  }
}

__device__ __forceinline__ void phase_final(CP4& p) {
  const float* gam = p.in[34];
  int tid_ = ltid(); int lane = tid_ & 63, wv = tid_ >> 6;
  for (int r = blockIdx.x * 8 + wv; r < NB * SEQ; r += gridDim.x * 8) {
    float* x = p.out + (size_t)r * D;
    f32x4 v[4]; float ss = 0.f;
#pragma unroll
    for (int i = 0; i < 4; ++i) { v[i] = *(const f32x4*)(x + i * 256 + lane * 4); ss += v[i][0] * v[i][0] + v[i][1] * v[i][1] + v[i][2] * v[i][2] + v[i][3] * v[i][3]; }
    ss = wave_sum(ss);
    float rs = rsqrtf(ss * (1.0f / D) + 1e-6f);
#pragma unroll
    for (int i = 0; i < 4; ++i) {
      int c = i * 256 + lane * 4;
      f32x4 gm = *(const f32x4*)(gam + c);
      f32x4 o = v[i] * rs * gm;
      *(f32x4*)(x + c) = o;
    }
  }
}

typedef unsigned u32x4 __attribute__((ext_vector_type(4)));
#define FMIX_LO(acc, m, u) asm("v_fma_mix_f32 %0, %1, %2, %0 op_sel:[0,0,0] op_sel_hi:[1,0,0]" : "+v"(acc) : "v"(m), "v"(u))
#define FMIX_HI(acc, m, u) asm("v_fma_mix_f32 %0, %1, %2, %0 op_sel:[1,0,0] op_sel_hi:[1,0,0]" : "+v"(acc) : "v"(m), "v"(u))
constexpr int TC = 16;
constexpr int SD_R = 0, SD_K = 4096, SD_V = 8192, SD_KKA = 12288, SD_LW = 16384, SD_LA = 18688, SD_RN = 20992, SD_RAW = 21120;
constexpr int SD_KK = SD_RAW, SD_W = SD_RAW + 4096;
constexpr int SD_AM = 32640, SD_BM = SD_AM + 2304, SD_CM = SD_BM + 2304, SD_RM = SD_CM + 2304;
constexpr int SD_BT = SD_RM + 2304, SD_CT = SD_BT + 3072, SD_VT = SD_CT + 3072;
constexpr int SD_WS = SD_VT + 3072, SD_WE = SD_WS + 256;
constexpr int SD_MCA = SD_WE + 256, SD_NBR = SD_MCA + 768, SD_NCR = SD_NBR + 768;
constexpr int SD_MBT = SD_NCR + 768;
constexpr int SD_XS = SD_MBT + 768;
constexpr int SD_SIZE = SD_XS + 4 * 1280;
static_assert(2 * SD_SIZE <= SHM_BYTES, "scan LDS layout");
constexpr int LWS = 72;
constexpr int TS = 24;
__device__ __forceinline__ void scan_chunk_geom(int c, int d, int bl, int& L, int& t0, int& rbase) {
  const int gb = (bl >> 2) * MG, b4 = bl & 3;
  if (c < CTX / TC) { L = CTX; t0 = d ? (CTX - TC * (c + 1)) : TC * c; rbase = gb + MLAT + b4 * CTX; }
  else { int cc = c - CTX / TC; L = SEQ; t0 = d ? (SEQ - TC * (cc + 1)) : TC * cc; rbase = gb + b4 * SEQ; }
}
__device__ __forceinline__ void scan_pair(CP4& p, int l, int bl, int hh, char* smc) {
  const h16* Z = (const h16*)(p.ws + OFF_ZR);
  h16* Y = (h16*)(p.ws + OFF_YH);
  const int tid = ltid(), lane = tid & 63, wv = __builtin_amdgcn_readfirstlane(tid >> 6), d = wv >> 2, wq = wv & 3, td = tid & 255;
  char* sd = smc + d * SD_SIZE;
  float* AR = (float*)(sd + SD_R); float* AK = (float*)(sd + SD_K); float* AV = (float*)(sd + SD_V);
  float* AKA = (float*)(sd + SD_KKA); float* AKK = (float*)(sd + SD_KK); float* AW = (float*)(sd + SD_W);
  float* RN = (float*)(sd + SD_RN);
  h16* LW = (h16*)(sd + SD_LW); h16* LA = (h16*)(sd + SD_LA);
  h16* AM = (h16*)(sd + SD_AM); h16* BM = (h16*)(sd + SD_BM); h16* CM = (h16*)(sd + SD_CM); h16* RM = (h16*)(sd + SD_RM);
  h16* BT = (h16*)(sd + SD_BT); h16* CT = (h16*)(sd + SD_CT); h16* VT = (h16*)(sd + SD_VT);
  float* WSC = (float*)(sd + SD_WS); float* WEC = (float*)(sd + SD_WE);
  h16* MCA = (h16*)(sd + SD_MCA); h16* NBR = (h16*)(sd + SD_NBR); h16* NCR = (h16*)(sd + SD_NCR);
  h16* MBT = (h16*)(sd + SD_MBT);
  float* XS = (float*)(sd + SD_XS + wq * 1280);
  const bool act1 = td < 240;
  const int c16 = td % 40, tk0 = td / 40, seg = c16 >> 3, cg = c16 & 7;
  const int segcol = ((seg < 3) ? seg * D + hh * 64 : (seg == 3 ? 3072 + d * 64 : 3200 + d * 64)) + cg * 8;
  const int cgA = lane & 7, tsA = lane >> 3;
  h16x8 swA0, swA1, swA2, swB0, swB1, swB2, kk8;
  {
    const int colA = ((wq < 3) ? wq * D + hh * 64 : 3072 + d * 64) + cgA * 8, colB = 3200 + d * 64 + cgA * 8;
    const float* sw = p.in[9] + (size_t)l * 3 * RC;
    const float* kkp = p.in[15] + l * D + hh * 64 + cgA * 8;
#pragma unroll
    for (int j = 0; j < 8; ++j) {
      swA0[j] = (h16)sw[colA + j]; swA1[j] = (h16)sw[RC + colA + j]; swA2[j] = (h16)sw[2 * RC + colA + j];
      swB0[j] = (h16)sw[colB + j]; swB1[j] = (h16)sw[RC + colB + j]; swB2[j] = (h16)sw[2 * RC + colB + j];
      kk8[j] = (h16)kkp[j];
    }
  }
  const int fr = lane & 15, fq = lane >> 4, jc = 16 * wq + fr;
  const float w0j = p.in[10][((size_t)l * 2 + d) * D + hh * 64 + jc];
  const float a0j = p.in[12][((size_t)l * 2 + d) * D + hh * 64 + jc];
  const float kkj = p.in[15][l * D + hh * 64 + jc];
  const float kaj = p.in[16][l * D + hh * 64 + jc];
  h16x8 Bw[2], Ba[2];
  {
    const float* wup = p.in[11] + ((size_t)l * 2 + d) * 64 * D + hh * 64 + jc;
    const float* aup = p.in[13] + ((size_t)l * 2 + d) * 64 * D + hh * 64 + jc;
#pragma unroll
    for (int ks = 0; ks < 2; ++ks)
#pragma unroll
      for (int jj = 0; jj < 8; ++jj) {
        int i = ks * 32 + fq * 8 + jj;
        Bw[ks][jj] = (h16)wup[(size_t)i * D];
        Ba[ks][jj] = (h16)aup[(size_t)i * D];
      }
  }
  f32x4 T[4];
#pragma unroll
  for (int n = 0; n < 4; ++n) T[n] = (f32x4){0.f, 0.f, 0.f, 0.f};
  const h16x8 zero8 = {0, 0, 0, 0, 0, 0, 0, 0};
  const int NCH = (CTX + SEQ) / TC;
  h16x8 pre[3];
#define RAW_LOAD(cn) do { int L_, t0_, rb_; scan_chunk_geom(cn, d, bl, L_, t0_, rb_); \
    _Pragma("unroll") for (int it = 0; it < 3; ++it) { const int row = tk0 + 6 * it; h16x8 v_ = {0, 0, 0, 0, 0, 0, 0, 0}; \
      if (act1) { int t_ = t0_ - 1 + row; \
        if (t_ >= 0 && t_ < L_) v_ = *(const h16x8*)(Z + (size_t)(rb_ + t_) * ZRW + segcol); } \
      pre[it] = v_; } } while (0)
#define RAW_STORE() do { _Pragma("unroll") for (int it = 0; it < 3; ++it) { const int row = tk0 + 6 * it; \
      if (act1) *(h16x8*)(sd + SD_RAW + row * 640 + c16 * 16) = pre[it]; } } while (0)
  __syncthreads();
  RAW_LOAD(0);
  RAW_STORE();
  __syncthreads();
#pragma unroll 1
  for (int c = 0; c < NCH; ++c) {
    int L, t0, rbase; scan_chunk_geom(c, d, bl, L, t0, rbase);
#pragma unroll
    for (int it = 0; it < 2; ++it) {
      const int tok = tsA + 8 * it;
      const char* rp = sd + SD_RAW + tok * 640 + (wq * 8 + cgA) * 16;
      const h16x8 ra = *(const h16x8*)rp, rb = *(const h16x8*)(rp + 640), rc = *(const h16x8*)(rp + 1280);
      float v[8];
#pragma unroll
      for (int j = 0; j < 8; ++j) v[j] = (float)ra[j] * (float)swA0[j] + (float)rb[j] * (float)swA1[j] + (float)rc[j] * (float)swA2[j];
      if (wq < 3) {
        float* dst = (wq == 0 ? AR : (wq == 1 ? AK : AV)) + tok * 64 + cgA * 8;
        *(float4*)dst = make_float4(v[0], v[1], v[2], v[3]);
        *(float4*)(dst + 4) = make_float4(v[4], v[5], v[6], v[7]);
        if (wq == 1) {
          float ss = 0.f;
#pragma unroll
          for (int j = 0; j < 8; ++j) { float t_ = v[j] * (float)kk8[j]; ss += t_ * t_; }
          ss += __shfl_xor(ss, 1, 64); ss += __shfl_xor(ss, 2, 64); ss += __shfl_xor(ss, 4, 64);
          if (cgA == 0) RN[tok] = rsqrtf(fmaxf(ss, 1e-24f));
        }
      } else {
        h16x8 o;
#pragma unroll
        for (int j = 0; j < 8; ++j) o[j] = (h16)tanhf_(v[j]);
        *(h16x8*)(LW + tok * LWS + cgA * 8) = o;
      }
    }
    if (lane < 32) {
      const int tok = tsA + 4 * wq;
      const char* rp = sd + SD_RAW + tok * 640 + (32 + cgA) * 16;
      const h16x8 ra = *(const h16x8*)rp, rb = *(const h16x8*)(rp + 640), rc = *(const h16x8*)(rp + 1280);
      h16x8 o;
#pragma unroll
      for (int j = 0; j < 8; ++j) o[j] = (h16)((float)ra[j] * (float)swB0[j] + (float)rb[j] * (float)swB1[j] + (float)rc[j] * (float)swB2[j]);
      *(h16x8*)(LA + tok * LWS + cgA * 8) = o;
    }
    __syncthreads();
    {
      f32x4 cw = {0.f, 0.f, 0.f, 0.f}, ca = {0.f, 0.f, 0.f, 0.f};
#pragma unroll
      for (int ks = 0; ks < 2; ++ks) {
        h16x8 alw = *(const h16x8*)(LW + fr * LWS + ks * 32 + fq * 8);
        h16x8 ala = *(const h16x8*)(LA + fr * LWS + ks * 32 + fq * 8);
        cw = __builtin_amdgcn_mfma_f32_16x16x32_f16(alw, Bw[ks], cw, 0, 0, 0);
        ca = __builtin_amdgcn_mfma_f32_16x16x32_f16(ala, Ba[ks], ca, 0, 0, 0);
      }
#pragma unroll
      for (int rg = 0; rg < 4; ++rg) {
        int tok = fq * 4 + rg;
        float dec = __expf(-0.6065306597126334f * sigmoidf_(cw[rg] + w0j));
        float a = sigmoidf_(ca[rg] + a0j);
        float k = AK[tok * 64 + jc];
        float kk = k * kkj * RN[tok];
        AKK[tok * 64 + jc] = kk;
        AKA[tok * 64 + jc] = kk * a;
        AW[tok * 64 + jc] = dec;
        AK[tok * 64 + jc] = k * (1.0f + (a - 1.0f) * kaj);
      }
    }
    if (c + 1 < NCH) RAW_LOAD(c + 1);
    __syncthreads();
    {
      float wref = 1.0f;
#pragma unroll
      for (int s = 0; s < 8; ++s) wref *= AW[(d ? (TC - 1 - s) : s) * 64 + lane];
      float qprev = __builtin_amdgcn_rcpf(wref);
      if (wq == 0) {
#pragma unroll
        for (int s = 0; s < TC; ++s) {
          const int tok = d ? (TC - 1 - s) : s;
          AM[s * LWS + lane] = (h16)(qprev * AKK[tok * 64 + lane]);
          qprev *= AW[tok * 64 + lane];
        }
      } else if (wq == 1) {
#pragma unroll
        for (int s = 0; s < TC; ++s) {
          const int tok = d ? (TC - 1 - s) : s;
          qprev *= AW[tok * 64 + lane];
          const h16 hb = (h16)(AKA[tok * 64 + lane] * __builtin_amdgcn_rcpf(qprev));
          BM[s * LWS + lane] = hb; BT[lane * TS + s] = -hb;
        }
      } else if (wq == 2) {
#pragma unroll
        for (int s = 0; s < TC; ++s) {
          const int tok = d ? (TC - 1 - s) : s;
          qprev *= AW[tok * 64 + lane];
          const h16 hc = (h16)(AK[tok * 64 + lane] * __builtin_amdgcn_rcpf(qprev));
          CM[s * LWS + lane] = hc; CT[lane * TS + s] = hc;
        }
      } else {
        WSC[lane] = wref;
#pragma unroll
        for (int s = 0; s < TC; ++s) {
          const int tok = d ? (TC - 1 - s) : s;
          qprev *= AW[tok * 64 + lane];
          RM[s * LWS + lane] = (h16)(qprev * AR[tok * 64 + lane]);
          VT[lane * TS + s] = (h16)AV[tok * 64 + lane];
        }
        WEC[lane] = qprev;
      }
    }
    __syncthreads();
    if (c + 1 < NCH) RAW_STORE();
    f32x4 P1 = {0.f, 0.f, 0.f, 0.f}, P2 = {0.f, 0.f, 0.f, 0.f};
    {
#pragma unroll
      for (int tt = 0; tt < 4; ++tt) { f32x4 sc = *(const f32x4*)(WSC + tt * 16 + fq * 4); T[tt] = T[tt] * sc; }
#pragma unroll
      for (int ks = 0; ks < 2; ++ks) {
        h16x8 tb;
#pragma unroll
        for (int e = 0; e < 4; ++e) { tb[e] = (h16)T[2 * ks][e]; tb[4 + e] = (h16)T[2 * ks + 1][e]; }
        const h16* ap = AM + fr * LWS + ks * 32 + fq * 4;
        const h16* rp = RM + fr * LWS + ks * 32 + fq * 4;
        h16x4 a0 = *(const h16x4*)ap, a1 = *(const h16x4*)(ap + 16), r0 = *(const h16x4*)rp, r1 = *(const h16x4*)(rp + 16);
        h16x8 af = {a0[0], a0[1], a0[2], a0[3], a1[0], a1[1], a1[2], a1[3]};
        h16x8 rf = {r0[0], r0[1], r0[2], r0[3], r1[0], r1[1], r1[2], r1[3]};
        P1 = __builtin_amdgcn_mfma_f32_16x16x32_f16(af, tb, P1, 0, 0, 0);
        P2 = __builtin_amdgcn_mfma_f32_16x16x32_f16(rf, tb, P2, 0, 0, 0);
      }
      const h16* lhs = (wq & 1) ? CM : BM;
      const h16* rhs = (wq & 2) ? RM : AM;
      f32x4 m = {0.f, 0.f, 0.f, 0.f};
#pragma unroll
      for (int ks = 0; ks < 2; ++ks) {
        h16x8 lf = *(const h16x8*)(lhs + fr * LWS + ks * 32 + fq * 8);
        h16x8 gf = *(const h16x8*)(rhs + fr * LWS + ks * 32 + fq * 8);
        m = __builtin_amdgcn_mfma_f32_16x16x32_f16(lf, gf, m, 0, 0, 0);
      }
#pragma unroll
      for (int r = 0; r < 4; ++r) { const int j = 4 * fq + r; const bool keep = (wq & 2) ? (j <= fr) : (j < fr); m[r] = keep ? m[r] : 0.f; }
      {
        if (wq == 0 || wq == 2) m = -m;
        h16x4 mh = {(h16)m[0], (h16)m[1], (h16)m[2], (h16)m[3]};
        *(h16x4*)((wq == 0 ? MBT : (wq == 1 ? MCA : (wq == 2 ? NBR : NCR))) + fr * TS + fq * 4) = mh;
      }
    }
    __syncthreads();
    {
      const bool lo2 = fq < 2;
      const h16x8 vf = lo2 ? *(const h16x8*)(VT + (wq * 16 + fr) * TS + fq * 8) : zero8;
      const h16x8 mcf = lo2 ? *(const h16x8*)(MCA + fr * TS + fq * 8) : zero8;
      f32x4 Xv = __builtin_amdgcn_mfma_f32_16x16x32_f16(mcf, vf, P1, 0, 0, 0);
      f32x4 ufin = {0.f, 0.f, 0.f, 0.f};
      {
        const h16x4 d1 = *(const h16x4*)(MBT + (4 * fq + 1) * TS + 4 * fq);
        const h16x4 d2 = *(const h16x4*)(MBT + (4 * fq + 2) * TS + 4 * fq);
        const h16x4 d3 = *(const h16x4*)(MBT + (4 * fq + 3) * TS + 4 * fq);
        const h16x4 ma = *(const h16x4*)(MBT + fr * TS + 4 * fq);
        const h16x8 maf = {ma[0], ma[1], ma[2], ma[3], 0, 0, 0, 0};
#pragma unroll
        for (int blk = 0; blk < 4; ++blk) {
          const float u0 = Xv[0];
          const float u1 = Xv[1] + (float)d1[0] * u0;
          const float u2 = Xv[2] + (float)d2[0] * u0 + (float)d2[1] * u1;
          const float u3 = Xv[3] + (float)d3[0] * u0 + (float)d3[1] * u1 + (float)d3[2] * u2;
          const bool mine = (fq == blk);
          ufin[0] = mine ? u0 : ufin[0]; ufin[1] = mine ? u1 : ufin[1]; ufin[2] = mine ? u2 : ufin[2]; ufin[3] = mine ? u3 : ufin[3];
          if (blk < 3) {
            const h16x8 ub = {(h16)u0, (h16)u1, (h16)u2, (h16)u3, 0, 0, 0, 0};
            Xv = __builtin_amdgcn_mfma_f32_16x16x32_f16(maf, mine ? ub : zero8, Xv, 0, 0, 0);
          }
        }
      }
      const h16x8 uf = {(h16)ufin[0], (h16)ufin[1], (h16)ufin[2], (h16)ufin[3], 0, 0, 0, 0};
      const h16x4 nb4 = *(const h16x4*)(NBR + fr * TS + 4 * fq);
      const h16x8 nbf = {nb4[0], nb4[1], nb4[2], nb4[3], 0, 0, 0, 0};
      const h16x8 ncf = lo2 ? *(const h16x8*)(NCR + fr * TS + fq * 8) : zero8;
      f32x4 Yv = __builtin_amdgcn_mfma_f32_16x16x32_f16(nbf, uf, P2, 0, 0, 0);
      Yv = __builtin_amdgcn_mfma_f32_16x16x32_f16(ncf, vf, Yv, 0, 0, 0);
      {
        h16* yb = Y + ((size_t)d * MALL + rbase + t0) * D + hh * 64 + wq * 16 + fr;
#pragma unroll
        for (int r = 0; r < 4; ++r) { const int s = 4 * fq + r; const int tok = d ? (TC - 1 - s) : s; yb[(size_t)tok * D] = (h16)(Yv[r] * YSC); }
      }
#pragma unroll
      for (int tt = 0; tt < 4; ++tt) {
        const h16x4 bt4 = *(const h16x4*)(BT + (tt * 16 + fr) * TS + fq * 4);
        const h16x8 btf = {bt4[0], bt4[1], bt4[2], bt4[3], 0, 0, 0, 0};
        const h16x8 ctf = lo2 ? *(const h16x8*)(CT + (tt * 16 + fr) * TS + fq * 8) : zero8;
        T[tt] = __builtin_amdgcn_mfma_f32_16x16x32_f16(btf, uf, T[tt], 0, 0, 0);
        T[tt] = __builtin_amdgcn_mfma_f32_16x16x32_f16(ctf, vf, T[tt], 0, 0, 0);
        f32x4 sc = *(const f32x4*)(WEC + tt * 16 + fq * 4);
        T[tt] = T[tt] * sc;
      }
    }
  }
#undef RAW_LOAD
#undef RAW_STORE
}

__device__ __forceinline__ void conv_unit(CP4& p, int l, int g, int rowbase, int stride, int L, int p0, char* smc) {
  const h16* Z = (const h16*)(p.ws + OFF_ZO + (size_t)(g & 1) * ZO_BYTES);
  h16* BP = (h16*)(p.ws + OFF_BPRE);
  h16* U = (h16*)smc;
  float* Yc = (float*)(smc + 62 * 512 * 2);
  int tid = ltid(), lane = tid & 63, wv = tid >> 6;
  __syncthreads();
#pragma unroll
  for (int i8 = 0; i8 < 8; ++i8) {
    const int pp = wv + 8 * i8;
    if (pp >= 62) break;
    int pos = p0 - 15 + pp;
    h16x8 o;
    if (pos >= 0 && pos < L) {
      size_t r = (size_t)(rowbase + pos * stride);
      h16x8 a = *(const h16x8*)(Z + r * ZOW + OC_CONV + lane * 8);
      h16x8 b = *(const h16x8*)(Z + r * ZOW + OC_CONV + 512 + lane * 8);
#pragma unroll
      for (int j = 0; j < 8; ++j) o[j] = (h16)((float)a[j] * sigmoidf_((float)b[j]));
    } else {
#pragma unroll
      for (int j = 0; j < 8; ++j) o[j] = (h16)0.f;
    }
    *(h16x8*)(U + pp * 512 + lane * 8) = o;
  }
  __syncthreads();
  {
    const float* dw = p.in[21] + (size_t)l * 31 * 512 + tid;
    float w[31];
#pragma unroll
    for (int j = 0; j < 31; ++j) w[j] = dw[j * 512];
    float bias = p.in[22][l * 512 + tid];
    float uin[62];
#pragma unroll
    for (int pp = 0; pp < 62; ++pp) uin[pp] = (float)U[pp * 512 + tid];
#pragma unroll
    for (int pp = 0; pp < 32; ++pp) {
      float acc = bias;
#pragma unroll
      for (int j = 0; j < 31; ++j) acc += uin[pp + j] * w[j];
      Yc[pp * 512 + tid] = acc;
    }
  }
  __syncthreads();
  const float* lg = p.in[23] + l * 512 + lane * 8;
  const float* lb = p.in[24] + l * 512 + lane * 8;
  for (int pp = wv; pp < 32; pp += 8) {
    float v[8]; float s = 0.f;
#pragma unroll
    for (int j = 0; j < 8; ++j) { v[j] = Yc[pp * 512 + lane * 8 + j]; s += v[j]; }
    float mean = wave_sum(s) * (1.0f / 512);
    float s2 = 0.f;
#pragma unroll
    for (int j = 0; j < 8; ++j) { v[j] -= mean; s2 += v[j] * v[j]; }
    float rstd = rsqrtf(wave_sum(s2) * (1.0f / 512) + 1e-5f);
    h16x8 o;
#pragma unroll
    for (int j = 0; j < 8; ++j) { float t = v[j] * rstd * lg[j] + lb[j]; o[j] = (h16)siluf_(t); }
    size_t r = (size_t)(rowbase + (p0 + pp) * stride);
    *(h16x8*)(BP + r * 512 + lane * 8) = o;
  }
}

__device__ __forceinline__ void sgu_unit(CP4& p, int l, int g, int row0, char* smc) {
  const h16* Z = (const h16*)(p.ws + OFF_ZO + (size_t)(g & 1) * ZO_BYTES);
  h16* CP = (h16*)(p.ws + OFF_CPRE);
  const h16* SW = (const h16*)(p.ws + OFF_SGUW);
  float* MEAN = (float*)smc;
  float* RSTD = MEAN + 128;
  h16* VT = (h16*)(smc + 1024);
  const int tid = ltid(), lane = tid & 63, wv = tid >> 6, fr = lane & 15, fq = lane >> 4;
  __syncthreads();
#pragma unroll 1
  for (int t4 = 0; t4 < 4; ++t4) {
    float s[4], s2[4];
#pragma unroll
    for (int k = 0; k < 4; ++k) {
      int tk = wv * 16 + t4 * 4 + k;
      h16x8 a = *(const h16x8*)(Z + (size_t)(row0 + tk) * ZOW + OC_SGU + 512 + lane * 8);
      s[k] = 0.f; s2[k] = 0.f;
#pragma unroll
      for (int j = 0; j < 8; ++j) { float v = geluf_((float)a[j]); s[k] += v; s2[k] += v * v; }
    }
#pragma unroll
    for (int m = 32; m >= 1; m >>= 1)
#pragma unroll
      for (int k = 0; k < 4; ++k) { s[k] += __shfl_xor(s[k], m, 64); s2[k] += __shfl_xor(s2[k], m, 64); }
    if (lane == 0) {
#pragma unroll
      for (int k = 0; k < 4; ++k) {
        float mean = s[k] * (1.0f / 512);
        float var = fmaxf(s2[k] * (1.0f / 512) - mean * mean, 0.f);
        MEAN[wv * 16 + t4 * 4 + k] = mean; RSTD[wv * 16 + t4 * 4 + k] = rsqrtf(var + 1e-5f);
      }
    }
  }
  __syncthreads();
  const float* lg = p.in[26] + l * 512;
  const float* lb = p.in[27] + l * 512;
  const float* bs = p.in[29] + (size_t)l * 8 * 128;
#pragma unroll 1
  for (int g8 = 0; g8 < 8; ++g8) {
    {
      const int qk = tid & 127, d0 = (tid >> 7) * 16;
      const float mean = MEAN[qk], rstd = RSTD[qk];
      const h16* src = Z + (size_t)(row0 + qk) * ZOW + OC_SGU + 512 + g8 * 64 + d0;
      h16x8 a0 = *(const h16x8*)src, a1 = *(const h16x8*)(src + 8);
#pragma unroll
      for (int j = 0; j < 8; ++j) {
        int c0 = g8 * 64 + d0 + j, c1 = c0 + 8;
        float v0 = (geluf_((float)a0[j]) - mean) * rstd * lg[c0] + lb[c0];
        float v1 = (geluf_((float)a1[j]) - mean) * rstd * lg[c1] + lb[c1];
        VT[(d0 + j) * 136 + qk] = (h16)v0;
        VT[(d0 + j + 8) * 136 + qk] = (h16)v1;
      }
    }
    __syncthreads();
    f32x4 acc[4];
#pragma unroll
    for (int dt = 0; dt < 4; ++dt) acc[dt] = (f32x4){0.f, 0.f, 0.f, 0.f};
#pragma unroll
    for (int ks = 0; ks < 4; ++ks) {
      h16x8 af = *(const h16x8*)(SW + ((size_t)g8 * 128 + wv * 16 + fr) * 128 + ks * 32 + fq * 8);
#pragma unroll
      for (int dt = 0; dt < 4; ++dt) {
        h16x8 bf = *(const h16x8*)(VT + (dt * 16 + fr) * 136 + ks * 32 + fq * 8);
        acc[dt] = __builtin_amdgcn_mfma_f32_16x16x32_f16(bf, af, acc[dt], 0, 0, 0);
      }
    }
    {
      const int pr = wv * 16 + fr;
      const float bias = bs[g8 * 128 + pr];
      const h16* up = Z + (size_t)(row0 + pr) * ZOW + OC_SGU + g8 * 64 + fq * 4;
      h16* cp = CP + (size_t)(row0 + pr) * 512 + g8 * 64 + fq * 4;
      h16x4 u4[4];
#pragma unroll
      for (int dt = 0; dt < 4; ++dt) u4[dt] = *(const h16x4*)(up + dt * 16);
#pragma unroll
      for (int dt = 0; dt < 4; ++dt) {
        h16x4 o;
#pragma unroll
        for (int j = 0; j < 4; ++j) o[j] = (h16)(geluf_((float)u4[dt][j]) * (acc[dt][j] + bias));
        *(h16x4*)(cp + dt * 16) = o;
      }
    }
    __syncthreads();
  }
}

__device__ __forceinline__ void phase_scan(CP4& p, int l, char* smc) {
  for (int pr = blockIdx.x; pr < NB * 16; pr += gridDim.x) scan_pair(p, l, pr >> 4, pr & 15, smc);
}
__device__ __forceinline__ void phase_convsgu(CP4& p, int l, int g, char* smc) {
  const bool last = (l == DEPTH - 1);
  int nb = gridDim.x, bi = blockIdx.x;
  int nconv_lat = GB * 64, nconv = nconv_lat + (last ? 0 : GB * 8);
  for (int u = (bi + nb - 144 % nb) % nb; u < nconv; u += nb) {
    int rowbase, stride, Lc, p0;
    if (u < nconv_lat) {
      int bl = u >> 6, w = u & 63;
      if ((l & 1) == 0) { rowbase = bl * SEQ + (w >> 1) * 64; stride = 1; Lc = 64; p0 = (w & 1) * 32; }
      else { rowbase = bl * SEQ + w; stride = 64; Lc = 32; p0 = 0; }
    } else {
      int uu = u - nconv_lat, bl = uu >> 3, sg = uu & 7;
      rowbase = MLAT + bl * CTX; stride = 1; Lc = CTX; p0 = sg * 32;
    }
    conv_unit(p, l, g, rowbase, stride, Lc, p0, smc);
  }
  int nsgu = last ? MLAT / 128 : MG / 128;
  for (int u = nb - 1 - bi; u < nsgu; u += nb) sgu_unit(p, l, g, u * 128, smc);
}

__device__ __forceinline__ void phase_postscan(CP4& p, int l, char* smc) {
  const bool last = (l == DEPTH - 1);
  const h16* Z = (const h16*)(p.ws + OFF_ZR);
  const h16* Y = (const h16*)(p.ws + OFF_YH);
  const h16* GT = (const h16*)(p.ws + OFF_GUPT);
  h16* AP = (h16*)(p.ws + OFF_APRE);
  const float* sw = p.in[9] + (size_t)l * 3 * RC;
  float* SWR = (float*)smc;
  float* GNC = SWR + 9 * 1024;
  h16* SG = (h16*)(GNC + 3 * 1024);
  h16* G = SG + 32 * 136;
  const int tid = ltid(), lane = tid & 63, wv = tid >> 6, fr = lane & 15, fq = lane >> 4;
  __syncthreads();
  for (int e = tid; e < 9 * 1024; e += NTHREADS) { int st = e >> 10, col = e & 1023, sg = st / 3, tap = st % 3; SWR[e] = sw[tap * RC + sg * D + col]; }
  for (int e = tid; e < 1024; e += NTHREADS) { GNC[e] = p.in[18][l * D + e]; GNC[1024 + e] = p.in[19][l * D + e]; GNC[2048 + e] = p.in[17][l * D + e]; }
  float sg0[8], sg1[8], sg2[8];
  {
    int kc = (tid & 15) * 8;
#pragma unroll
    for (int j = 0; j < 8; ++j) { sg0[j] = sw[3328 + kc + j]; sg1[j] = sw[RC + 3328 + kc + j]; sg2[j] = sw[2 * RC + 3328 + kc + j]; }
  }
  const h16x8 zero8 = {0, 0, 0, 0, 0, 0, 0, 0};
  const int ntiles = MALL / 32;
  for (int u = blockIdx.x; u < ntiles; u += gridDim.x) {
    const int row0 = u * 32;
    if (last && (row0 % MG) >= MLAT) continue;
    __syncthreads();
    {
      int tok = tid >> 4, kc = (tid & 15) * 8;
      int r = row0 + tok, t, L; seqposG(r, t, L);
      const h16* zp = Z + (size_t)r * ZRW + 3328 + kc;
      h16x8 b = *(const h16x8*)zp;
      h16x8 a = (t > 0) ? *(const h16x8*)(zp - ZRW) : zero8;
      h16x8 c = (t < L - 1) ? *(const h16x8*)(zp + ZRW) : zero8;
      h16x8 o;
#pragma unroll
      for (int j = 0; j < 8; ++j) o[j] = (h16)sigmoidf_((float)a[j] * sg0[j] + (float)b[j] * sg1[j] + (float)c[j] * sg2[j]);
      *(h16x8*)(SG + tok * 136 + kc) = o;
    }
    __syncthreads();
    {
      h16x8 af[2][4];
#pragma unroll
      for (int m = 0; m < 2; ++m)
#pragma unroll
        for (int ks = 0; ks < 4; ++ks) af[m][ks] = *(const h16x8*)(SG + (m * 16 + fr) * 136 + ks * 32 + fq * 8);
#pragma unroll
      for (int nt = 0; nt < 8; ++nt) {
        f32x4 acc0 = {0.f, 0.f, 0.f, 0.f}, acc1 = {0.f, 0.f, 0.f, 0.f};
        const h16* bp = GT + (size_t)(wv * 128 + nt * 16 + fr) * 128 + fq * 8;
#pragma unroll
        for (int ks = 0; ks < 4; ++ks) {
          h16x8 bf = *(const h16x8*)(bp + ks * 32);
          acc0 = __builtin_amdgcn_mfma_f32_16x16x32_f16(af[0][ks], bf, acc0, 0, 0, 0);
          acc1 = __builtin_amdgcn_mfma_f32_16x16x32_f16(af[1][ks], bf, acc1, 0, 0, 0);
        }
#pragma unroll
        for (int rg = 0; rg < 4; ++rg) {
          G[(fq * 4 + rg) * 1024 + wv * 128 + nt * 16 + fr] = (h16)acc0[rg];
          G[(16 + fq * 4 + rg) * 1024 + wv * 128 + nt * 16 + fr] = (h16)acc1[rg];
        }
      }
    }
    __syncthreads();
#pragma unroll 1
    for (int it = 0; it < 8; ++it) {
      const int tok = (tid >> 7) + 4 * it, col = (tid & 127) * 8;
      const int r = row0 + tok; int t, L; seqposG(r, t, L);
      const bool hp = t > 0, hn = t < L - 1;
      const h16* zp = Z + (size_t)r * ZRW + col;
      h16x8 yf = *(const h16x8*)(Y + (size_t)r * D + col), yb = *(const h16x8*)(Y + ((size_t)MALL + r) * D + col);
      h16x8 z[3][3];
#pragma unroll
      for (int sg = 0; sg < 3; ++sg) {
        z[sg][1] = *(const h16x8*)(zp + sg * D);
        z[sg][0] = hp ? *(const h16x8*)(zp + sg * D - ZRW) : zero8;
        z[sg][2] = hn ? *(const h16x8*)(zp + sg * D + ZRW) : zero8;
      }
      float y[8], s = 0.f;
#pragma unroll
      for (int j = 0; j < 8; ++j) { y[j] = ((float)yf[j] + (float)yb[j]) * YUN; s += y[j]; }
      s += __shfl_xor(s, 1, 64); s += __shfl_xor(s, 2, 64); s += __shfl_xor(s, 4, 64);
      const float mean = s * (1.0f / 64);
      float s2 = 0.f;
#pragma unroll
      for (int j = 0; j < 8; ++j) { y[j] -= mean; s2 += y[j] * y[j]; }
      s2 += __shfl_xor(s2, 1, 64); s2 += __shfl_xor(s2, 2, 64); s2 += __shfl_xor(s2, 4, 64);
      const float rstd = rsqrtf(s2 * (1.0f / 64) + 64e-5f);
      float vv[8], bs = 0.f;
#pragma unroll
      for (int j = 0; j < 8; ++j) {
        float rr = (float)z[0][0][j] * SWR[0 * 1024 + col + j] + (float)z[0][1][j] * SWR[1 * 1024 + col + j] + (float)z[0][2][j] * SWR[2 * 1024 + col + j];
        float kk = (float)z[1][0][j] * SWR[3 * 1024 + col + j] + (float)z[1][1][j] * SWR[4 * 1024 + col + j] + (float)z[1][2][j] * SWR[5 * 1024 + col + j];
        vv[j] = (float)z[2][0][j] * SWR[6 * 1024 + col + j] + (float)z[2][1][j] * SWR[7 * 1024 + col + j] + (float)z[2][2][j] * SWR[8 * 1024 + col + j];
        bs += rr * kk * GNC[2048 + col + j];
      }
      bs += __shfl_xor(bs, 1, 64); bs += __shfl_xor(bs, 2, 64); bs += __shfl_xor(bs, 4, 64);
      const h16x8 g8 = *(const h16x8*)(G + tok * 1024 + col);
      h16x8 o;
#pragma unroll
      for (int j = 0; j < 8; ++j) {
        float yn = y[j] * rstd * GNC[col + j] + GNC[1024 + col + j];
        o[j] = (h16)((yn + bs * vv[j]) * (float)g8[j]);
      }
      *(h16x8*)(AP + (size_t)r * D + col) = o;
    }
  }
}

constexpr int NLS = 5, NST = 6, NLE = 3;
constexpr int NPL = NLS + NG * NST + NLE;
constexpr int NPHASE = 2 + DEPTH * NPL + 1;

__device__ __forceinline__ void decode_phase(int ph, int& kind, int& l, int& g, int& st) {
  l = g = st = 0;
  if (ph == 0) { kind = 0; return; }
  if (ph == 1) { kind = 1; return; }
  if (ph == NPHASE - 1) { kind = 2; return; }
  int q = ph - 2; l = q / NPL; int s = q % NPL;
  if (s < NLS) { kind = 3; st = s; return; }
  s -= NLS;
  if (s < NG * NST) { kind = 4; g = s / NST; st = s % NST; return; }
  kind = 3; st = NLS + (s - NG * NST);
}
__device__ __forceinline__ bool step_needs_sync(int kind, int l, int g, int st) {
  if (kind == 3 && st == 0 && l > 0) return false;
  if (kind != 4) return true;
  if (st == 0) return g == 0;
  return st == 2 || st == 4 || st == 5;
}

__device__ __forceinline__ void run_nongemm(CP4& p, int kind, int l, int g, int st, char* smc) {
  if (kind == 0) phase_mod(p, (float*)smc);
  else if (kind == 1) phase_copyx(p);
  else if (kind == 2) phase_final(p);
  else if (kind == 3) {
    if (st == 1) phase_norm(p, l, 0);
    else if (st == 3) phase_scan(p, l, smc);
    else if (st == 4) phase_postscan(p, l, smc);
    else if (st == 5) phase_norm(p, l, 1);
  } else {
    if (st == 1) phase_convsgu(p, l, g, smc);
  }
}

__device__ __forceinline__ int opq(int x) { asm volatile("" : "+v"(x)); return __builtin_amdgcn_readfirstlane(x); }
__device__ __forceinline__ size_t opq64(size_t x) { int lo = opq((int)(unsigned)x), hi = opq((int)(unsigned)(x >> 32)); return ((size_t)(unsigned)hi << 32) | (unsigned)lo; }
struct GemmDesc { size_t offA, offB, offO, offZ; int K, nM, nN, mode, goff, ldo, ubeg, uend, brot, nblk, valid; };
__device__ __forceinline__ GemmDesc gemm_desc(int kind, int l, int g, int st, int j) {
  const bool last = (l == DEPTH - 1);
  const int nMr = (last ? MLAT : MG) / BM;
  const int grid = gridDim.x;
  GemmDesc d{};
  d.brot = 0; d.nblk = grid; d.valid = 0; d.offZ = OFF_ZO + (size_t)(g & 1) * ZO_BYTES;
  if (kind == 3) {
    if (j != 0) return d;
    d.valid = 1;
    if (st == 2) { d.offA = OFF_HALL; d.offB = OFF_WINT; d.offO = OFF_ZR; d.K = D; d.nM = MALL / BM; d.nN = ZRW / BM; d.mode = 0; d.ldo = ZRW; }
    else if (st == 6) { d.offA = OFF_HALL; d.offB = OFF_FFNINT; d.offO = OFF_HID; d.K = D; d.nM = MALL / BM; d.nN = 2 * DFF / BM; d.mode = 5; d.ldo = DFF; }
    else if (st == 7) { d.offA = OFF_HID; d.offB = (l & 1) ? OFF_FFNOUTT2 : OFF_FFNOUTT; d.offO = OFF_HID; d.K = DFF; d.nM = MALL / BM; d.nN = D / BM; d.mode = 4; d.goff = 5120; d.ldo = D; }
    else d.valid = 0;
    d.ubeg = 0; d.uend = d.nM * d.nN;
    return d;
  }
  if (kind != 4) return d;
  const bool shadow = (j > 0);
  const int gz = shadow ? g + 1 : g;
  if ((st == 0 && j == 0 && g == 0) || (shadow && gz < NG && ((st == 4 && j == 1) || (st == 5)))) {
    d.valid = 1;
    d.offA = OFF_HALL + (size_t)gz * MG * D * 2; d.offB = OFF_WINT + (size_t)ZRW * D * 2; d.offO = OFF_ZO + (size_t)(gz & 1) * ZO_BYTES;
    d.K = D; d.nM = nMr; d.nN = ZOW / BM; d.mode = 0; d.ldo = ZOW;
    const int tot = d.nM * d.nN;
    d.ubeg = 0; d.uend = tot;
    if (shadow) {
      const int nsh = grid > 144 ? grid - 144 : 0;
      const int nA = min(3 * nsh, tot), nB1 = min(nA + 2 * nsh, tot);
      if (st == 4) { d.ubeg = 0; d.uend = nA; d.brot = 144; d.nblk = nsh; }
      else if (j == 1) { d.ubeg = nA; d.uend = nB1; d.brot = 144; d.nblk = nsh; }
      else { d.ubeg = nB1; d.uend = tot; d.brot = 0; d.nblk = grid; }
      if (d.ubeg >= d.uend) d.valid = 0;
    }
    return d;
  }
  if (j != 0) return d;
  d.valid = 1; d.nM = nMr; d.nN = D / BM; d.ldo = D; d.offO = OFF_M16;
  if (st == 2) { d.offA = OFF_APRE + (size_t)g * MG * D * 2; d.offB = OFF_ROUTT; d.K = 1024; d.mode = 1; }
  else if (st == 3) { d.offA = OFF_BPRE; d.offB = OFF_COUTT; d.K = 512; d.mode = 2; }
  else if (st == 4) { d.offA = OFF_CPRE; d.offB = OFF_SOUTT; d.K = 512; d.mode = 3; }
  else if (st == 5) { d.offA = OFF_M16; d.offB = OFF_WMT; d.K = D; d.mode = 4; d.goff = 2048; }
  else d.valid = 0;
  d.ubeg = 0; d.uend = d.nM * d.nN;
  return d;
}

__global__ void __launch_bounds__(NTHREADS) mk(P p, int ph0, int ph1, int coop) {
  extern __shared__ __attribute__((aligned(16))) char smc[];
  cg::grid_group grid = cg::this_grid();
  CP4* pp = (CP4*)__builtin_amdgcn_kernarg_segment_ptr();
  unsigned nbar = 0;
#pragma nounroll
  for (int ph = ph0; ph < ph1; ++ph) {
    CP4* q = pp;
    asm volatile("" : "+s"(q));
    int kind, l, g, st; decode_phase(ph, kind, l, g, st);
    run_nongemm(*q, kind, l, g, st, smc);
#pragma nounroll
    for (int j = 0; j < 3; ++j) {
      GemmDesc d = gemm_desc(kind, l, g, st, j);
      d.offA = opq64(d.offA); d.offB = opq64(d.offB); d.offO = opq64(d.offO); d.offZ = opq64(d.offZ);
      d.K = opq(d.K); d.nM = opq(d.nM); d.nN = opq(d.nN); d.mode = opq(d.mode); d.goff = opq(d.goff); d.ldo = opq(d.ldo);
      d.ubeg = opq(d.ubeg); d.uend = opq(d.uend); d.brot = opq(d.brot); d.nblk = opq(d.nblk); d.valid = opq(d.valid);
      if (!d.valid) continue;
      char* ws = q->ws;
      EpiAny e{d.mode, (h16*)(ws + d.offO), (const h16*)(ws + d.offZ), nullptr, q->out, ws, l, (kind == 3 ? 0 : g), d.goff, d.ldo};
      gemm_phase((LAS unsigned char*)smc, (const h16*)(ws + d.offA), (const h16*)(ws + d.offB), d.K, 0, d.nM, d.nN, d.ubeg, d.uend, d.brot, d.nblk, e);
    }
    {
      int cl = -1, cb0 = 0;
      if (kind == 3 && st == 0 && l == 0) cl = 0;
      if (kind == 3 && st == 7 && l + 1 < DEPTH) { cl = l + 1; cb0 = (gridDim.x > 128) ? 64 : 0; }
      if (cl >= 0) phase_convert(*q, cl, (float*)smc, cb0, (int)gridDim.x - cb0);
    }
    if (coop && ph + 1 < ph1 && step_needs_sync(kind, l, g, st) && ph >= 2) {
      if (ph == 2) grid.sync();
      else { ++nbar; grid_bar((unsigned*)(q->ws + OFF_BAR), nbar * gridDim.x); }
    }
  }
}

extern "C" void kernel_launch(void* const* d_in, const int* in_sizes, int n_in, void* d_out, int out_size, void* d_ws, size_t ws_size,
                              hipStream_t stream) {
  if (ws_size < WS_TOTAL) return;
  P p{};
  for (int i = 0; i < 35; ++i) p.in[i] = (const float*)d_in[i];
  p.out = (float*)d_out;
  p.ws = (char*)d_ws;
  static bool attr = false;
  if (!attr) { (void)hipFuncSetAttribute((const void*)mk, hipFuncAttributeMaxDynamicSharedMemorySize, SHM_BYTES); attr = true; }
#if COOP
  static int grid_blocks = 0;
  if (!grid_blocks) {
    int dev = 0, cus = 0, per_cu = 0;
    (void)hipGetDevice(&dev);
    (void)hipDeviceGetAttribute(&cus, hipDeviceAttributeMultiprocessorCount, dev);
    (void)hipOccupancyMaxActiveBlocksPerMultiprocessor(&per_cu, mk, NTHREADS, SHM_BYTES);
    grid_blocks = cus;
  }
  (void)hipMemsetAsync((char*)d_ws + OFF_BAR, 0, 256, stream);
  int ph0 = 0, ph1 = NPHASE, coop = 1;
  void* args[] = {&p, &ph0, &ph1, &coop};
  (void)hipLaunchCooperativeKernel((void*)mk, dim3(grid_blocks), dim3(NTHREADS), args, SHM_BYTES, stream);
#else
  for (int ph = 0; ph < NPHASE; ++ph) mk<<<256, NTHREADS, SHM_BYTES, stream>>>(p, ph, ph + 1, 0);
#endif
}
```

```cpp
#include <hip/hip_runtime.h>
#include <hip/hip_cooperative_groups.h>
namespace cg = cooperative_groups;

#ifndef REP_SCAN
#define REP_SCAN 1
#endif
#ifndef REP_POST
#define REP_POST 1
#endif
#ifndef REP_CS
#define REP_CS 1
#endif
#ifndef REP_ZR
#define REP_ZR 1
#endif
#ifndef COOP
#define COOP 1
#endif

typedef _Float16 h16;
typedef _Float16 h16x8 __attribute__((ext_vector_type(8)));
typedef _Float16 h16x4 __attribute__((ext_vector_type(4)));
typedef float f32x4 __attribute__((ext_vector_type(4)));
typedef float f32x2 __attribute__((ext_vector_type(2)));

constexpr int D = 1024, NB = 16, SEQ = 2048, DEPTH = 4, CTX = 256;
constexpr int PIN = 8576, PINP = 8704, RC = 3456;
constexpr int ZRW = 3584;
constexpr int ZOW = 5120;
constexpr int OC_CONV = 0, OC_SGU = 1024, OC_GATE = 2048;
constexpr int DFF = 2816;
constexpr int GB = 4, NG = NB / GB;
constexpr int MLAT = GB * SEQ, MCTX = GB * CTX, MG = MLAT + MCTX;
constexpr int NLAT = NB * SEQ, MALL = NB * (SEQ + CTX);
constexpr int NTHREADS = 512;
constexpr int SHM_BYTES = 131072;
constexpr float YSC = 0.0625f, YUN = 16.0f;

constexpr size_t al256(size_t x) { return (x + 255) / 256 * 256; }
constexpr size_t OFF_MOD = 0;
constexpr size_t OFF_BAR = al256(OFF_MOD + (size_t)4 * 17 * 6144 * 4);
constexpr size_t OFF_CTXX = al256(OFF_BAR + 256);
constexpr size_t OFF_WINT = al256(OFF_CTXX + (size_t)NB * CTX * D * 4);
constexpr size_t OFF_FFNINT = al256(OFF_WINT + (size_t)PINP * D * 2);
constexpr size_t OFF_FFNOUTT = al256(OFF_FFNINT + (size_t)2 * DFF * D * 2);
constexpr size_t OFF_ROUTT = al256(OFF_FFNOUTT + (size_t)D * DFF * 2);
constexpr size_t OFF_WMT = al256(OFF_ROUTT + (size_t)D * D * 2);
constexpr size_t OFF_COUTT = al256(OFF_WMT + (size_t)D * D * 2);
constexpr size_t OFF_SOUTT = al256(OFF_COUTT + (size_t)D * 512 * 2);
constexpr size_t OFF_SGUW = al256(OFF_SOUTT + (size_t)D * 512 * 2);
constexpr size_t OFF_GUPT = al256(OFF_SGUW + (size_t)8 * 128 * 128 * 2);
constexpr size_t OFF_HALL = al256(OFF_GUPT + (size_t)D * 128 * 2);
constexpr size_t OFF_YH = al256(OFF_HALL + (size_t)MALL * D * 2);
constexpr size_t OFF_APRE = OFF_YH;
constexpr size_t OFF_ZR = al256(OFF_YH + (size_t)2 * MALL * D * 2);
constexpr size_t OFF_FFNOUTT2 = al256(OFF_ZR + (size_t)MALL * ZRW * 2);
constexpr size_t WS_TOTAL = al256(OFF_FFNOUTT2 + (size_t)D * DFF * 2);
constexpr size_t ZO_BYTES = (size_t)MG * ZOW * 2;
constexpr size_t OFF_ZO = OFF_ZR;
constexpr size_t OFF_BPRE = al256(OFF_ZO + 2 * ZO_BYTES);
constexpr size_t OFF_CPRE = al256(OFF_BPRE + (size_t)MG * 512 * 2);
constexpr size_t OFF_M16 = al256(OFF_CPRE + (size_t)MG * 512 * 2);
constexpr size_t OFF_HID = OFF_ZR;
static_assert(OFF_M16 + (size_t)MG * D * 2 <= OFF_FFNOUTT2, "group buffers must fit in the ZR region");
static_assert(OFF_HID + (size_t)MALL * DFF * 2 <= OFF_FFNOUTT2, "ffn hidden must fit in the ZR region");

struct P {
  const float* in[35];
  float* out;
  char* ws;
};
typedef const __attribute__((address_space(4))) P CP4;

__device__ __forceinline__ float wave_sum(float v) {
#pragma unroll
  for (int m = 32; m >= 1; m >>= 1) v += __shfl_xor(v, m, 64);
  return v;
}
__device__ __forceinline__ int ltid() { int t = threadIdx.x; asm volatile("" : "+v"(t)); return t; }
__device__ __forceinline__ float sigmoidf_(float x) { return __builtin_amdgcn_rcpf(1.0f + __expf(-x)); }
__device__ __forceinline__ float siluf_(float x) { return x * sigmoidf_(x); }
__device__ __forceinline__ float tanhf_(float x) { return 1.0f - 2.0f * __builtin_amdgcn_rcpf(1.0f + __expf(2.0f * x)); }
__device__ __forceinline__ float geluf_(float x) {
  float u = 0.7978845608028654f * (x + 0.044715f * x * x * x);
  return x * __builtin_amdgcn_rcpf(1.0f + __expf(-2.0f * u));
}
__device__ __forceinline__ float* xrow2(float* out, char* ws, int g, int r) {
  return (r < MLAT) ? out + ((size_t)g * MLAT + r) * D
                    : (float*)(ws + OFF_CTXX) + ((size_t)g * MCTX + (r - MLAT)) * D;
}
__device__ __forceinline__ const float* modrow2(const char* ws, int l, int g, int r) {
  int i = (r < MLAT) ? (g * GB + r / SEQ) : 16;
  return (const float*)(ws + OFF_MOD) + ((size_t)l * 17 + i) * 6144;
}
__device__ __forceinline__ float* xrow(CP4& p, int g, int r) { return xrow2(p.out, p.ws, g, r); }
__device__ __forceinline__ const float* modrow(CP4& p, int l, int g, int r) { return modrow2(p.ws, l, g, r); }
__device__ __forceinline__ void seqposG(int R, int& t, int& L) {
  int lr = R % MG;
  if (lr < MLAT) { t = lr % SEQ; L = SEQ; } else { t = (lr - MLAT) % CTX; L = CTX; }
}
__device__ __forceinline__ float zshift(const h16* Z, const float* sw, int r, int t, int L, int col) {
  float v = (float)Z[(size_t)r * ZRW + col] * sw[RC + col];
  if (t > 0) v += (float)Z[(size_t)(r - 1) * ZRW + col] * sw[col];
  if (t < L - 1) v += (float)Z[(size_t)(r + 1) * ZRW + col] * sw[2 * RC + col];
  return v;
}
__device__ __forceinline__ void grid_bar(unsigned* ctr, unsigned target) {
  asm volatile("s_waitcnt vmcnt(0) lgkmcnt(0)" ::: "memory");
  __syncthreads();
  if (threadIdx.x == 0) {
    __builtin_amdgcn_fence(__ATOMIC_RELEASE, "agent");
    asm volatile("s_waitcnt vmcnt(0)" ::: "memory");
    __hip_atomic_fetch_add(ctr, 1u, __ATOMIC_RELAXED, __HIP_MEMORY_SCOPE_AGENT);
    while (__hip_atomic_load(ctr, __ATOMIC_RELAXED, __HIP_MEMORY_SCOPE_AGENT) < target) __builtin_amdgcn_s_sleep(1);
    __builtin_amdgcn_fence(__ATOMIC_ACQUIRE, "agent");
    asm volatile("s_waitcnt vmcnt(0)" ::: "memory");
  }
  __syncthreads();
}

#define LAS __attribute__((address_space(3)))
constexpr int BM = 256, BK = 64, HALF = 128, HTB = HALF * BK * 2;
__device__ __forceinline__ int lds_byte(int r, int c) {
  int st = (r >> 4) * 2 + (c >> 5), rr = r & 15, cc = c & 31, ob = rr * 64 + cc * 2;
  return st * 1024 + (ob ^ (((ob >> 9) & 1) << 5));
}
__device__ __forceinline__ void stage_rc(int b, int& R, int& C) {
  int st = b / 1024, sb = b % 1024, swz = sb ^ (((sb >> 9) & 1) << 5);
  R = (st >> 1) * 16 + swz / 64; C = (st & 1) * 32 + (swz % 64) / 2;
}
__device__ __forceinline__ bool tile_of(int i, int nM, int nN, int ubeg, int uend, int brot, int nblk, int& pm, int& pn) {
  const int NXCD = 8, WGM = 8;
  int nwg = nM * nN;
  int bsub = (int)blockIdx.x - brot; if (bsub < 0) bsub += gridDim.x;
  if (bsub >= nblk) return false;
  long Lq = (long)ubeg + (long)i * nblk + bsub; if (Lq >= uend) return false;
  int wgid = (int)Lq;
  { int q = nwg / NXCD, r = nwg % NXCD, xcd = wgid % NXCD, off = wgid / NXCD;
    wgid = (xcd < r ? xcd * (q + 1) : r * (q + 1) + (xcd - r) * q) + off; }
  int nig = WGM * nN, gid = wgid / nig, fm = gid * WGM, gsz = min(nM - fm, WGM);
  pm = fm + ((wgid % nig) % gsz); pn = (wgid % nig) / gsz;
  return true;
}

template <class Epi>
__device__ __forceinline__ void gemm_phase(LAS unsigned char* lds, const h16* Ag, const h16* Btg, int K, int row0, int nM, int nN, int ubeg, int uend, int brot, int nblk, const Epi& E) {
  const int tid = threadIdx.x, wid = __builtin_amdgcn_readfirstlane(tid >> 6), lane = tid & 63, wr = wid >> 2, wc = wid & 3, fr = lane & 15, fq = lane >> 4;
  const int nt = K / BK;
  unsigned voffA[2];
#pragma unroll
  for (int i = 0; i < 2; ++i) { int R, C; stage_rc(tid * 16 + i * 8192, R, C); voffA[i] = (unsigned)(R * K + C) * 2u; }
  const size_t kstep = (size_t)(BK * 2);
  const size_t hstep = (size_t)HALF * K * 2;
  const size_t tstep = 2 * hstep;
  const unsigned ldsw = (unsigned)wid * 1024u;
  const int aoff = lds_byte(wr * 64 + fr, fq * 8), boff = lds_byte(wc * 32 + fr, fq * 8);
  const char* Abase = (const char*)(Ag + (size_t)row0 * K);
#define PG8_SA(b, h) (((b) * 2 + (h)) * HTB)
#define PG8_SB(b, h) ((4 + (b) * 2 + (h)) * HTB)
#define PG8_STAGE(bufoff, gbase, voff) do { _Pragma("unroll") for (int _i = 0; _i < 2; ++_i) \
    __builtin_amdgcn_global_load_lds((const unsigned*)((const char*)(gbase) + (voff)[_i]), (LAS unsigned*)(lds + (bufoff) + ldsw + _i * 8192), 16, 0, 0); } while (0)
#define PG8_LDA(dst, b, h) do { _Pragma("unroll") for (int m = 0; m < 4; ++m) _Pragma("unroll") for (int k = 0; k < 2; ++k) dst[m][k] = *(const LAS h16x8*)(lds + PG8_SA(b, h) + aoff + m * 2048 + k * 1024); } while (0)
#define PG8_LDB(dst, b, h) do { _Pragma("unroll") for (int n = 0; n < 2; ++n) _Pragma("unroll") for (int k = 0; k < 2; ++k) dst[n][k] = *(const LAS h16x8*)(lds + PG8_SB(b, h) + boff + n * 2048 + k * 1024); } while (0)
#define PG8_MMA(ai, bj, At, Bt) do { __builtin_amdgcn_s_setprio(1); _Pragma("unroll") for (int m = 0; m < 4; ++m) _Pragma("unroll") for (int n = 0; n < 2; ++n) _Pragma("unroll") for (int k = 0; k < 2; ++k) \
    acc[ai][bj][m][n] = __builtin_amdgcn_mfma_f32_16x16x32_f16(Bt[n][k], At[m][k], acc[ai][bj][m][n], 0, 0, 0); __builtin_amdgcn_s_setprio(0); } while (0)
#define PG8_WAIT_V(n) asm volatile("s_waitcnt vmcnt(" #n ")" ::: "memory")
#define PG8_WAIT_L(n) asm volatile("s_waitcnt lgkmcnt(" #n ")" ::: "memory")
#define PG8_BAR __builtin_amdgcn_s_barrier()
#define PG8_SCHED __builtin_amdgcn_sched_barrier(0)
  int cpm, cpn, npm, npn, ui = 0;
  __syncthreads();
  if (!tile_of(0, nM, nN, ubeg, uend, brot, nblk, cpm, cpn)) return;
  f32x4 acc[2][2][4][2];
#pragma unroll
  for (int a = 0; a < 2; ++a)
#pragma unroll
    for (int b = 0; b < 2; ++b)
#pragma unroll
      for (int m = 0; m < 4; ++m)
#pragma unroll
        for (int n = 0; n < 2; ++n) acc[a][b][m][n] = (f32x4){0.f, 0.f, 0.f, 0.f};
  h16x8 At[4][2], B0[2][2], B1[2][2];
  const char* cA = Abase + (size_t)cpm * tstep; const char* cB = (const char*)Btg + (size_t)cpn * tstep;
  PG8_STAGE(PG8_SB(0, 0), cB, voffA); PG8_STAGE(PG8_SA(0, 0), cA, voffA); PG8_STAGE(PG8_SB(0, 1), cB + hstep, voffA); PG8_STAGE(PG8_SA(0, 1), cA + hstep, voffA);
  if (wr == 1) PG8_BAR;
  PG8_WAIT_V(4); PG8_BAR;
  PG8_STAGE(PG8_SB(1, 0), cB + kstep, voffA); PG8_STAGE(PG8_SA(1, 0), cA + kstep, voffA); PG8_STAGE(PG8_SB(1, 1), cB + hstep + kstep, voffA);
  PG8_WAIT_V(6); PG8_BAR;
  for (;;) {
    const bool has_next = tile_of(ui + 1, nM, nN, ubeg, uend, brot, nblk, npm, npn);
    const char* nA = has_next ? Abase + (size_t)npm * tstep : cA; const char* nB = has_next ? (const char*)Btg + (size_t)npn * tstep : cB;
    for (int t = 0; t < nt; t += 2) {
      const bool last = (t == nt - 2);
      const char* a1 = cA + (size_t)(t + 1) * kstep;
      const char* a2 = last ? nA : cA + (size_t)(t + 2) * kstep; const char* b2 = last ? nB : cB + (size_t)(t + 2) * kstep;
      const char* a3 = a2 + kstep; const char* b3 = b2 + kstep;
      PG8_LDB(B0, 0, 0); PG8_SCHED; PG8_LDA(At, 0, 0); PG8_STAGE(PG8_SA(1, 1), a1 + hstep, voffA);
      PG8_WAIT_L(8); PG8_BAR; PG8_WAIT_L(0); PG8_MMA(0, 0, At, B0); PG8_BAR; PG8_SCHED;
      PG8_LDB(B1, 0, 1); PG8_STAGE(PG8_SB(0, 0), b2, voffA);
      PG8_BAR; PG8_WAIT_L(0); PG8_MMA(0, 1, At, B1); PG8_BAR;
      PG8_LDA(At, 0, 1); PG8_STAGE(PG8_SA(0, 0), a2, voffA);
      PG8_BAR; PG8_WAIT_L(0); PG8_MMA(1, 0, At, B0); PG8_BAR; PG8_SCHED;
      PG8_STAGE(PG8_SB(0, 1), b2 + hstep, voffA);
      PG8_WAIT_V(6); PG8_BAR; PG8_MMA(1, 1, At, B1); PG8_BAR;
      PG8_LDB(B0, 1, 0); PG8_SCHED; PG8_LDA(At, 1, 0); PG8_STAGE(PG8_SA(0, 1), a2 + hstep, voffA);
      PG8_WAIT_L(8); PG8_BAR; PG8_WAIT_L(0); PG8_MMA(0, 0, At, B0); PG8_BAR; PG8_SCHED;
      PG8_LDB(B1, 1, 1); PG8_STAGE(PG8_SB(1, 0), b3, voffA);
      PG8_BAR; PG8_WAIT_L(0); PG8_MMA(0, 1, At, B1); PG8_BAR;
      PG8_LDA(At, 1, 1); PG8_STAGE(PG8_SA(1, 0), a3, voffA);
      PG8_BAR; PG8_WAIT_L(0); PG8_MMA(1, 0, At, B0); PG8_BAR; PG8_SCHED;
      PG8_STAGE(PG8_SB(1, 1), b3 + hstep, voffA);
      PG8_WAIT_V(6); PG8_BAR; PG8_MMA(1, 1, At, B1); PG8_BAR;
    }
    E(acc, row0 + cpm * BM, cpn * BM, wr, wc, fr, fq);
    if (!has_next) break;
#pragma unroll
    for (int a = 0; a < 2; ++a)
#pragma unroll
      for (int b = 0; b < 2; ++b)
#pragma unroll
        for (int m = 0; m < 4; ++m)
#pragma unroll
          for (int n = 0; n < 2; ++n) acc[a][b][m][n] = (f32x4){0.f, 0.f, 0.f, 0.f};
    cpm = npm; cpn = npn; cA = nA; cB = nB; ++ui;
  }
  PG8_WAIT_V(0);
  if (wr == 0) PG8_BAR;
  PG8_BAR;
#undef PG8_SA
#undef PG8_SB
#undef PG8_STAGE
#undef PG8_LDA
#undef PG8_LDB
#undef PG8_MMA
}

struct EpiAny {
  int mode; h16* O16; const h16* Z; float* MT; float* out; char* ws; int l, g, goff, ldo;
  __device__ __forceinline__ void operator()(const f32x4 (&acc)[2][2][4][2], int brow, int bcol, int wr, int wc, int fr, int fq) const {
    if (mode == 0) {
#pragma unroll
      for (int ai = 0; ai < 2; ++ai)
#pragma unroll
        for (int m = 0; m < 4; ++m) {
          int row = brow + ai * 128 + wr * 64 + m * 16 + fr;
#pragma unroll
          for (int bj = 0; bj < 2; ++bj) {
            int col = bcol + bj * 128 + wc * 32 + fq * 8;
            f32x4 a = acc[ai][bj][m][0], b = acc[ai][bj][m][1];
            h16x8 o = {(h16)a[0], (h16)a[1], (h16)a[2], (h16)a[3], (h16)b[0], (h16)b[1], (h16)b[2], (h16)b[3]};
            *(h16x8*)(O16 + (size_t)row * ldo + col) = o;
          }
        }
    } else if (mode <= 3) {
      const int bm = mode - 1;
#pragma unroll
      for (int ai = 0; ai < 2; ++ai) {
        h16x8 gts[4][2], old[4][2];
#pragma unroll
        for (int m = 0; m < 4; ++m) {
          int row = brow + ai * 128 + wr * 64 + m * 16 + fr;
#pragma unroll
          for (int bj = 0; bj < 2; ++bj) {
            int col = bcol + bj * 128 + wc * 32 + fq * 8;
            gts[m][bj] = *(const h16x8*)(Z + (size_t)row * ZOW + OC_GATE + bm * D + col);
            if (bm != 0) old[m][bj] = *(const h16x8*)(O16 + (size_t)row * D + col);
          }
        }
#pragma unroll
        for (int m = 0; m < 4; ++m) {
          int row = brow + ai * 128 + wr * 64 + m * 16 + fr;
#pragma unroll
          for (int bj = 0; bj < 2; ++bj) {
            int col = bcol + bj * 128 + wc * 32 + fq * 8;
            const h16x8 gt = gts[m][bj];
            f32x4 a = acc[ai][bj][m][0], b = acc[ai][bj][m][1];
            float v[8];
#pragma unroll
            for (int j = 0; j < 4; ++j) { v[j] = a[j] * sigmoidf_((float)gt[j]); v[4 + j] = b[j] * sigmoidf_((float)gt[4 + j]); }
            if (bm != 0) {
#pragma unroll
              for (int j = 0; j < 8; ++j) v[j] += (float)old[m][bj][j]; }
            h16x8 hv;
#pragma unroll
            for (int j = 0; j < 8; ++j) hv[j] = (h16)v[j];
            *(h16x8*)(O16 + (size_t)row * D + col) = hv;
          }
        }
      }
    } else if (mode == 4) {
      f32x4 gt[2][2];
      {
        const int gg0 = g + brow / MG, lr0 = brow % MG;
        const float* md = modrow2(ws, l, gg0, lr0) + goff;
#pragma unroll
        for (int bj = 0; bj < 2; ++bj)
#pragma unroll
          for (int n = 0; n < 2; ++n) gt[bj][n] = *(const f32x4*)(md + bcol + bj * 128 + wc * 32 + n * 16 + fq * 4);
      }
#pragma unroll
      for (int ai = 0; ai < 2; ++ai) {
        f32x4 o[4][2][2]; float* xrs[4];
#pragma unroll
        for (int m = 0; m < 4; ++m) {
          int row = brow + ai * 128 + wr * 64 + m * 16 + fr;
          const int gg = g + row / MG, lr = row % MG;
          float* xr = xrow2(out, ws, gg, lr);
          xrs[m] = xr;
#pragma unroll
          for (int bj = 0; bj < 2; ++bj)
#pragma unroll
            for (int n = 0; n < 2; ++n) o[m][bj][n] = *(const f32x4*)(xr + bcol + bj * 128 + wc * 32 + n * 16 + fq * 4);
        }
#pragma unroll
        for (int m = 0; m < 4; ++m)
#pragma unroll
          for (int bj = 0; bj < 2; ++bj)
#pragma unroll
            for (int n = 0; n < 2; ++n)
              *(f32x4*)(xrs[m] + bcol + bj * 128 + wc * 32 + n * 16 + fq * 4) = o[m][bj][n] + gt[bj][n] * acc[ai][bj][m][n];
      }
    } else {
      int hb = (bcol >> 8) * 128;
#pragma unroll
      for (int ai = 0; ai < 2; ++ai)
#pragma unroll
        for (int m = 0; m < 4; ++m) {
          int row = brow + ai * 128 + wr * 64 + m * 16 + fr;
          int col = hb + wc * 32 + fq * 8;
          h16x8 o;
#pragma unroll
          for (int n = 0; n < 2; ++n) {
            f32x4 a = acc[ai][0][m][n], b = acc[ai][1][m][n];
#pragma unroll
            for (int j = 0; j < 4; ++j) o[n * 4 + j] = (h16)(siluf_(a[j]) * b[j]);
          }
          *(h16x8*)(O16 + (size_t)row * DFF + col) = o;
        }
    }
  }
};

__device__ __forceinline__ void phase_mod(CP4& p, float* sm) {
  float* SC = sm;
  float* RED = sm + 17 * 1024;
  int tid = ltid();
  for (int u = blockIdx.x; u < 4 * 48; u += gridDim.x) {
    int l = u / 48, cb = (u % 48) * 128;
    __syncthreads();
    for (int e = tid; e < 17 * 1024; e += NTHREADS) {
      int i = e >> 10, k = e & 1023;
      float c = (i < 16) ? p.in[1][i * 1024 + k] : p.in[3][k];
      SC[e] = siluf_(c);
    }
    __syncthreads();
    int cj = tid & 127, kq = tid >> 7;
    const float* W = p.in[4] + (size_t)l * 1024 * 6144 + cb + cj;
    float acc[17];
#pragma unroll
    for (int i = 0; i < 17; ++i) acc[i] = 0.f;
    for (int k = kq * 256; k < kq * 256 + 256; k += 4) {
      float w0 = W[(size_t)k * 6144], w1 = W[(size_t)(k + 1) * 6144], w2 = W[(size_t)(k + 2) * 6144], w3 = W[(size_t)(k + 3) * 6144];
#pragma unroll
      for (int i = 0; i < 17; ++i) {
        float4 s = *(const float4*)(SC + i * 1024 + k);
        acc[i] += s.x * w0 + s.y * w1 + s.z * w2 + s.w * w3;
      }
    }
#pragma unroll
    for (int i = 0; i < 17; ++i) RED[(kq * 17 + i) * 128 + cj] = acc[i];
    __syncthreads();
    if (kq == 0) {
      float* MO = (float*)(p.ws + OFF_MOD);
      float b = p.in[5][l * 6144 + cb + cj];
#pragma unroll
      for (int i = 0; i < 17; ++i) {
        float v = RED[(0 * 17 + i) * 128 + cj] + RED[(1 * 17 + i) * 128 + cj] + RED[(2 * 17 + i) * 128 + cj] + RED[(3 * 17 + i) * 128 + cj];
        MO[((size_t)l * 17 + i) * 6144 + cb + cj] = v + b;
      }
    }
  }
}

__device__ __forceinline__ void phase_copyx(CP4& p) {
  size_t n1 = (size_t)NB * SEQ * D / 4, n2 = (size_t)NB * CTX * D / 4;
  const float4* s1 = (const float4*)p.in[0]; float4* d1 = (float4*)p.out;
  const float4* s2 = (const float4*)p.in[2]; float4* d2 = (float4*)(p.ws + OFF_CTXX);
  size_t stride = (size_t)gridDim.x * NTHREADS;
  size_t i = (size_t)blockIdx.x * NTHREADS + ltid();
  for (; i + 3 * stride < n1; i += 4 * stride) {
    float4 a = s1[i], b = s1[i + stride], c = s1[i + 2 * stride], e = s1[i + 3 * stride];
    d1[i] = a; d1[i + stride] = b; d1[i + 2 * stride] = c; d1[i + 3 * stride] = e;
  }
  for (; i < n1; i += stride) d1[i] = s1[i];
  i = (size_t)blockIdx.x * NTHREADS + ltid();
  for (; i + 3 * stride < n2; i += 4 * stride) {
    float4 a = s2[i], b = s2[i + stride], c = s2[i + 2 * stride], e = s2[i + 3 * stride];
    d2[i] = a; d2[i + stride] = b; d2[i + 2 * stride] = c; d2[i + 3 * stride] = e;
  }
  for (; i < n2; i += stride) d2[i] = s2[i];
}

__device__ __forceinline__ int perm32(int rho) { const int n = rho >> 4, i = rho & 15; return 8 * (i >> 2) + 4 * n + (i & 3); }
__device__ __forceinline__ void tr_job(const float* src, int K, int Nsrc, h16* dst, int Ndst, int mode, bool perm, float* T, int b0, int nb) {
  int tk = K / 64, tn = Ndst / 64;
  int tid = ltid();
  if ((int)blockIdx.x < b0) return;
  const int lk = tid >> 4, lc = (tid & 15) * 4;
  const int sn = tid >> 3, sk = (tid & 7) * 8;
  const int ln = perm ? ((sn & 32) + perm32(sn & 31)) : sn;
  for (int u = blockIdx.x - b0; u < tk * tn; u += nb) {
    int k0 = (u % tk) * 64, n0 = (u / tk) * 64;
    int sn0;
    if (mode == 1) { int pn = n0 >> 8, j = n0 & 255; sn0 = (j < 128) ? pn * 128 + j : DFF + pn * 128 + (j - 128); }
    else if (mode == 2) sn0 = (n0 < RC) ? n0 : (n0 < ZRW ? Nsrc : n0 - (ZRW - RC));
    else sn0 = n0;
    bool valid = sn0 < Nsrc;
    f32x4 v0 = {0.f, 0.f, 0.f, 0.f}, v1 = {0.f, 0.f, 0.f, 0.f};
    if (valid) {
      v0 = *(const f32x4*)(src + (size_t)(k0 + lk) * Nsrc + sn0 + lc);
      v1 = *(const f32x4*)(src + (size_t)(k0 + lk + 32) * Nsrc + sn0 + lc);
    }
    __syncthreads();
    *(f32x4*)(T + lk * 68 + lc) = v0;
    *(f32x4*)(T + (lk + 32) * 68 + lc) = v1;
    __syncthreads();
    h16x8 o;
#pragma unroll
    for (int e = 0; e < 8; ++e) o[e] = (h16)T[(sk + e) * 68 + ln];
    *(h16x8*)(dst + (size_t)(n0 + sn) * K + k0 + sk) = o;
  }
}
__device__ __forceinline__ void phase_convert(CP4& p, int l, float* sm, int b0, int nb) {
  tr_job(p.in[8] + (size_t)l * D * PIN, D, PIN, (h16*)(p.ws + OFF_WINT), PINP, 2, true, sm, b0, nb);
  tr_job(p.in[32] + (size_t)l * D * 2 * DFF, D, 2 * DFF, (h16*)(p.ws + OFF_FFNINT), 2 * DFF, 1, true, sm, b0, nb);
  tr_job(p.in[33] + (size_t)l * DFF * D, DFF, D, (h16*)(p.ws + ((l & 1) ? OFF_FFNOUTT2 : OFF_FFNOUTT)), D, 0, false, sm, b0, nb);
  tr_job(p.in[20] + (size_t)l * D * D, D, D, (h16*)(p.ws + OFF_ROUTT), D, 0, true, sm, b0, nb);
  tr_job(p.in[31] + (size_t)l * D * D, D, D, (h16*)(p.ws + OFF_WMT), D, 0, false, sm, b0, nb);
  tr_job(p.in[25] + (size_t)l * 512 * D, 512, D, (h16*)(p.ws + OFF_COUTT), D, 0, true, sm, b0, nb);
  tr_job(p.in[30] + (size_t)l * 512 * D, 512, D, (h16*)(p.ws + OFF_SOUTT), D, 0, true, sm, b0, nb);
  tr_job(p.in[14] + (size_t)l * 128 * D, 128, D, (h16*)(p.ws + OFF_GUPT), D, 0, false, sm, b0, nb);
  if ((int)blockIdx.x < b0) return;
  const float* sw = p.in[28] + (size_t)l * 8 * 128 * 128;
  h16* dw = (h16*)(p.ws + OFF_SGUW);
  for (int i = (blockIdx.x - b0) * NTHREADS + ltid(); i < 8 * 128 * 128; i += nb * NTHREADS) dw[i] = (h16)sw[i];
}

__device__ __forceinline__ void phase_norm(CP4& p, int l, int which) {
  const float* gam = p.in[which ? 7 : 6] + l * D;
  h16* H = (h16*)(p.ws + OFF_HALL);
  int tid_ = ltid(); int lane = tid_ & 63, wv = tid_ >> 6;
  for (int r = blockIdx.x * 8 + wv; r < MALL; r += gridDim.x * 8) {
    int g = r / MG, lr = r % MG;
    const float* x = xrow(p, g, lr);
    const float* md = modrow(p, l, g, lr) + which * 3072;
    f32x4 v[4]; float ss = 0.f;
#pragma unroll
    for (int i = 0; i < 4; ++i) { v[i] = *(const f32x4*)(x + i * 256 + lane * 4); ss += v[i][0] * v[i][0] + v[i][1] * v[i][1] + v[i][2] * v[i][2] + v[i][3] * v[i][3]; }
    ss = wave_sum(ss);
    float rs = rsqrtf(ss * (1.0f / D) + 1e-6f);
    f32x4 gm[4], sh[4], sc[4];
#pragma unroll
    for (int i = 0; i < 4; ++i) { int c = i * 256 + lane * 4; gm[i] = *(const f32x4*)(gam + c); sh[i] = *(const f32x4*)(md + c); sc[i] = *(const f32x4*)(md + D + c); }
#pragma unroll
    for (int i = 0; i < 4; ++i) {
      int c = i * 256 + lane * 4;
      h16x4 o;
#pragma unroll
      for (int j = 0; j < 4; ++j) o[j] = (h16)((v[i][j] * rs * gm[i][j]) * (1.0f + sc[i][j]) + sh[i][j]);
      *(h16x4*)(H + (size_t)r * D + c) = o;
    }
  }
}

__device__ __forceinline__ void phase_final(CP4& p) {
  const float* gam = p.in[34];
  int tid_ = ltid(); int lane = tid_ & 63, wv = tid_ >> 6;
  for (int r = blockIdx.x * 8 + wv; r < NB * SEQ; r += gridDim.x * 8) {
    float* x = p.out + (size_t)r * D;
    f32x4 v[4]; float ss = 0.f;
#pragma unroll
    for (int i = 0; i < 4; ++i) { v[i] = *(const f32x4*)(x + i * 256 + lane * 4); ss += v[i][0] * v[i][0] + v[i][1] * v[i][1] + v[i][2] * v[i][2] + v[i][3] * v[i][3]; }
    ss = wave_sum(ss);
    float rs = rsqrtf(ss * (1.0f / D) + 1e-6f);
    f32x4 gmf[4];
#pragma unroll
    for (int i = 0; i < 4; ++i) gmf[i] = *(const f32x4*)(gam + i * 256 + lane * 4);
#pragma unroll
    for (int i = 0; i < 4; ++i) {
      int c = i * 256 + lane * 4;
      f32x4 o = v[i] * rs * gmf[i];
      *(f32x4*)(x + c) = o;
    }
  }
}

typedef unsigned u32x4 __attribute__((ext_vector_type(4)));
#define FMIX_LO(acc, m, u) asm("v_fma_mix_f32 %0, %1, %2, %0 op_sel:[0,0,0] op_sel_hi:[1,0,0]" : "+v"(acc) : "v"(m), "v"(u))
#define FMIX_HI(acc, m, u) asm("v_fma_mix_f32 %0, %1, %2, %0 op_sel:[1,0,0] op_sel_hi:[1,0,0]" : "+v"(acc) : "v"(m), "v"(u))
constexpr int TC = 16;
constexpr int SD_R = 0, SD_K = 4096, SD_V = 8192, SD_KKA = 12288, SD_LW = 16384, SD_LA = 18688, SD_RN = 20992, SD_RAW = 21120;
constexpr int SD_KK = SD_RAW, SD_W = SD_RAW + 4096;
constexpr int SD_AM = 32640, SD_BM = SD_AM + 2304, SD_CM = SD_BM + 2304, SD_RM = SD_CM + 2304;
constexpr int SD_BT = SD_RM + 2304, SD_CT = SD_BT + 3072, SD_VT = SD_CT + 3072;
constexpr int SD_WS = SD_VT + 3072, SD_WE = SD_WS + 256;
constexpr int SD_MCA = SD_WE + 256, SD_NBR = SD_MCA + 768, SD_NCR = SD_NBR + 768;
constexpr int SD_MBT = SD_NCR + 768;
constexpr int SD_XS = SD_MBT + 768;
constexpr int SD_SIZE = SD_XS + 4 * 1280;
static_assert(2 * SD_SIZE <= SHM_BYTES, "scan LDS layout");
constexpr int LWS = 72;
constexpr int TS = 24;
__device__ __forceinline__ void scan_chunk_geom(int c, int d, int bl, int& L, int& t0, int& rbase) {
  const int gb = (bl >> 2) * MG, b4 = bl & 3;
  if (c < CTX / TC) { L = CTX; t0 = d ? (CTX - TC * (c + 1)) : TC * c; rbase = gb + MLAT + b4 * CTX; }
  else { int cc = c - CTX / TC; L = SEQ; t0 = d ? (SEQ - TC * (cc + 1)) : TC * cc; rbase = gb + b4 * SEQ; }
}
__device__ __forceinline__ void scan_pair(CP4& p, int l, int bl, int hh, char* smc) {
  const h16* Z = (const h16*)(p.ws + OFF_ZR);
  h16* Y = (h16*)(p.ws + OFF_YH);
  const int tid = ltid(), lane = tid & 63, wv = __builtin_amdgcn_readfirstlane(tid >> 6), d = wv >> 2, wq = wv & 3, td = tid & 255;
  char* sd = smc + d * SD_SIZE;
  float* AR = (float*)(sd + SD_R); float* AK = (float*)(sd + SD_K); float* AV = (float*)(sd + SD_V);
  float* AKA = (float*)(sd + SD_KKA); float* AKK = (float*)(sd + SD_KK); float* AW = (float*)(sd + SD_W);
  float* RN = (float*)(sd + SD_RN);
  h16* LW = (h16*)(sd + SD_LW); h16* LA = (h16*)(sd + SD_LA);
  h16* AM = (h16*)(sd + SD_AM); h16* BM = (h16*)(sd + SD_BM); h16* CM = (h16*)(sd + SD_CM); h16* RM = (h16*)(sd + SD_RM);
  h16* BT = (h16*)(sd + SD_BT); h16* CT = (h16*)(sd + SD_CT); h16* VT = (h16*)(sd + SD_VT);
  float* WSC = (float*)(sd + SD_WS); float* WEC = (float*)(sd + SD_WE);
  h16* MCA = (h16*)(sd + SD_MCA); h16* NBR = (h16*)(sd + SD_NBR); h16* NCR = (h16*)(sd + SD_NCR);
  h16* MBT = (h16*)(sd + SD_MBT);
  float* XS = (float*)(sd + SD_XS + wq * 1280);
  const bool act1 = td < 240;
  const int c16 = td % 40, tk0 = td / 40, seg = c16 >> 3, cg = c16 & 7;
  const int segcol = ((seg < 3) ? seg * D + hh * 64 : (seg == 3 ? 3072 + d * 64 : 3200 + d * 64)) + cg * 8;
  const int cgA = lane & 7, tsA = lane >> 3;
  h16x8 swA0, swA1, swA2, swB0, swB1, swB2, kk8;
  {
    const int colA = ((wq < 3) ? wq * D + hh * 64 : 3072 + d * 64) + cgA * 8, colB = 3200 + d * 64 + cgA * 8;
    const float* sw = p.in[9] + (size_t)l * 3 * RC;
    const float* kkp = p.in[15] + l * D + hh * 64 + cgA * 8;
#pragma unroll
    for (int j = 0; j < 8; ++j) {
      swA0[j] = (h16)sw[colA + j]; swA1[j] = (h16)sw[RC + colA + j]; swA2[j] = (h16)sw[2 * RC + colA + j];
      swB0[j] = (h16)sw[colB + j]; swB1[j] = (h16)sw[RC + colB + j]; swB2[j] = (h16)sw[2 * RC + colB + j];
      kk8[j] = (h16)kkp[j];
    }
  }
  const int fr = lane & 15, fq = lane >> 4, jc = 16 * wq + fr;
  const float w0j = p.in[10][((size_t)l * 2 + d) * D + hh * 64 + jc];
  const float a0j = p.in[12][((size_t)l * 2 + d) * D + hh * 64 + jc];
  const float kkj = p.in[15][l * D + hh * 64 + jc];
  const float kaj = p.in[16][l * D + hh * 64 + jc];
  h16x8 Bw[2], Ba[2];
  {
    const float* wup = p.in[11] + ((size_t)l * 2 + d) * 64 * D + hh * 64 + jc;
    const float* aup = p.in[13] + ((size_t)l * 2 + d) * 64 * D + hh * 64 + jc;
#pragma unroll
    for (int ks = 0; ks < 2; ++ks)
#pragma unroll
      for (int jj = 0; jj < 8; ++jj) {
        int i = ks * 32 + fq * 8 + jj;
        Bw[ks][jj] = (h16)wup[(size_t)i * D];
        Ba[ks][jj] = (h16)aup[(size_t)i * D];
      }
  }
  f32x4 T[4];
#pragma unroll
  for (int n = 0; n < 4; ++n) T[n] = (f32x4){0.f, 0.f, 0.f, 0.f};
  const h16x8 zero8 = {0, 0, 0, 0, 0, 0, 0, 0};
  const int NCH = (CTX + SEQ) / TC;
  h16x8 pre[3];
#define RAW_LOAD(cn) do { int L_, t0_, rb_; scan_chunk_geom(cn, d, bl, L_, t0_, rb_); \
    _Pragma("unroll") for (int it = 0; it < 3; ++it) { const int row = tk0 + 6 * it; h16x8 v_ = {0, 0, 0, 0, 0, 0, 0, 0}; \
      if (act1) { int t_ = t0_ - 1 + row; \
        if (t_ >= 0 && t_ < L_) v_ = *(const h16x8*)(Z + (size_t)(rb_ + t_) * ZRW + segcol); } \
      pre[it] = v_; } } while (0)
#define RAW_STORE() do { _Pragma("unroll") for (int it = 0; it < 3; ++it) { const int row = tk0 + 6 * it; \
      if (act1) *(h16x8*)(sd + SD_RAW + row * 640 + c16 * 16) = pre[it]; } } while (0)
  __syncthreads();
  RAW_LOAD(0);
  RAW_STORE();
  __syncthreads();
#pragma unroll 1
  for (int c = 0; c < NCH; ++c) {
    int L, t0, rbase; scan_chunk_geom(c, d, bl, L, t0, rbase);
#pragma unroll
    for (int it = 0; it < 2; ++it) {
      const int tok = tsA + 8 * it;
      const char* rp = sd + SD_RAW + tok * 640 + (wq * 8 + cgA) * 16;
      const h16x8 ra = *(const h16x8*)rp, rb = *(const h16x8*)(rp + 640), rc = *(const h16x8*)(rp + 1280);
      float v[8];
#pragma unroll
      for (int j = 0; j < 8; ++j) v[j] = (float)ra[j] * (float)swA0[j] + (float)rb[j] * (float)swA1[j] + (float)rc[j] * (float)swA2[j];
      if (wq < 3) {
        float* dst = (wq == 0 ? AR : (wq == 1 ? AK : AV)) + tok * 64 + cgA * 8;
        *(float4*)dst = make_float4(v[0], v[1], v[2], v[3]);
        *(float4*)(dst + 4) = make_float4(v[4], v[5], v[6], v[7]);
        if (wq == 1) {
          float ss = 0.f;
#pragma unroll
          for (int j = 0; j < 8; ++j) { float t_ = v[j] * (float)kk8[j]; ss += t_ * t_; }
          ss += __shfl_xor(ss, 1, 64); ss += __shfl_xor(ss, 2, 64); ss += __shfl_xor(ss, 4, 64);
          if (cgA == 0) RN[tok] = rsqrtf(fmaxf(ss, 1e-24f));
        }
      } else {
        h16x8 o;
#pragma unroll
        for (int j = 0; j < 8; ++j) o[j] = (h16)tanhf_(v[j]);
        *(h16x8*)(LW + tok * LWS + cgA * 8) = o;
      }
    }
    if (lane < 32) {
      const int tok = tsA + 4 * wq;
      const char* rp = sd + SD_RAW + tok * 640 + (32 + cgA) * 16;
      const h16x8 ra = *(const h16x8*)rp, rb = *(const h16x8*)(rp + 640), rc = *(const h16x8*)(rp + 1280);
      h16x8 o;
#pragma unroll
      for (int j = 0; j < 8; ++j) o[j] = (h16)((float)ra[j] * (float)swB0[j] + (float)rb[j] * (float)swB1[j] + (float)rc[j] * (float)swB2[j]);
      *(h16x8*)(LA + tok * LWS + cgA * 8) = o;
    }
    __syncthreads();
    {
      f32x4 cw = {0.f, 0.f, 0.f, 0.f}, ca = {0.f, 0.f, 0.f, 0.f};
#pragma unroll
      for (int ks = 0; ks < 2; ++ks) {
        h16x8 alw = *(const h16x8*)(LW + fr * LWS + ks * 32 + fq * 8);
        h16x8 ala = *(const h16x8*)(LA + fr * LWS + ks * 32 + fq * 8);
        cw = __builtin_amdgcn_mfma_f32_16x16x32_f16(alw, Bw[ks], cw, 0, 0, 0);
        ca = __builtin_amdgcn_mfma_f32_16x16x32_f16(ala, Ba[ks], ca, 0, 0, 0);
      }
#pragma unroll
      for (int rg = 0; rg < 4; ++rg) {
        int tok = fq * 4 + rg;
        float dec = __expf(-0.6065306597126334f * sigmoidf_(cw[rg] + w0j));
        float a = sigmoidf_(ca[rg] + a0j);
        float k = AK[tok * 64 + jc];
        float kk = k * kkj * RN[tok];
        AKK[tok * 64 + jc] = kk;
        AKA[tok * 64 + jc] = kk * a;
        AW[tok * 64 + jc] = dec;
        AK[tok * 64 + jc] = k * (1.0f + (a - 1.0f) * kaj);
      }
    }
    if (c + 1 < NCH) RAW_LOAD(c + 1);
    __syncthreads();
    {
      float wref = 1.0f;
#pragma unroll
      for (int s = 0; s < 8; ++s) wref *= AW[(d ? (TC - 1 - s) : s) * 64 + lane];
      float qprev = __builtin_amdgcn_rcpf(wref);
      if (wq == 0) {
#pragma unroll
        for (int s = 0; s < TC; ++s) {
          const int tok = d ? (TC - 1 - s) : s;
          AM[s * LWS + lane] = (h16)(qprev * AKK[tok * 64 + lane]);
          qprev *= AW[tok * 64 + lane];
        }
      } else if (wq == 1) {
#pragma unroll
        for (int s = 0; s < TC; ++s) {
          const int tok = d ? (TC - 1 - s) : s;
          qprev *= AW[tok * 64 + lane];
          const h16 hb = (h16)(AKA[tok * 64 + lane] * __builtin_amdgcn_rcpf(qprev));
          BM[s * LWS + lane] = hb; BT[lane * TS + s] = -hb;
        }
      } else if (wq == 2) {
#pragma unroll
        for (int s = 0; s < TC; ++s) {
          const int tok = d ? (TC - 1 - s) : s;
          qprev *= AW[tok * 64 + lane];
          const h16 hc = (h16)(AK[tok * 64 + lane] * __builtin_amdgcn_rcpf(qprev));
          CM[s * LWS + lane] = hc; CT[lane * TS + s] = hc;
        }
      } else {
        WSC[lane] = wref;
#pragma unroll
        for (int s = 0; s < TC; ++s) {
          const int tok = d ? (TC - 1 - s) : s;
          qprev *= AW[tok * 64 + lane];
          RM[s * LWS + lane] = (h16)(qprev * AR[tok * 64 + lane]);
          VT[lane * TS + s] = (h16)AV[tok * 64 + lane];
        }
        WEC[lane] = qprev;
      }
    }
    __syncthreads();
    if (c + 1 < NCH) RAW_STORE();
    f32x4 P1 = {0.f, 0.f, 0.f, 0.f}, P2 = {0.f, 0.f, 0.f, 0.f};
    {
#pragma unroll
      for (int tt = 0; tt < 4; ++tt) { f32x4 sc = *(const f32x4*)(WSC + tt * 16 + fq * 4); T[tt] = T[tt] * sc; }
#pragma unroll
      for (int ks = 0; ks < 2; ++ks) {
        h16x8 tb;
#pragma unroll
        for (int e = 0; e < 4; ++e) { tb[e] = (h16)T[2 * ks][e]; tb[4 + e] = (h16)T[2 * ks + 1][e]; }
        const h16* ap = AM + fr * LWS + ks * 32 + fq * 4;
        const h16* rp = RM + fr * LWS + ks * 32 + fq * 4;
        h16x4 a0 = *(const h16x4*)ap, a1 = *(const h16x4*)(ap + 16), r0 = *(const h16x4*)rp, r1 = *(const h16x4*)(rp + 16);
        h16x8 af = {a0[0], a0[1], a0[2], a0[3], a1[0], a1[1], a1[2], a1[3]};
        h16x8 rf = {r0[0], r0[1], r0[2], r0[3], r1[0], r1[1], r1[2], r1[3]};
        P1 = __builtin_amdgcn_mfma_f32_16x16x32_f16(af, tb, P1, 0, 0, 0);
        P2 = __builtin_amdgcn_mfma_f32_16x16x32_f16(rf, tb, P2, 0, 0, 0);
      }
      const h16* lhs = (wq & 1) ? CM : BM;
      const h16* rhs = (wq & 2) ? RM : AM;
      f32x4 m = {0.f, 0.f, 0.f, 0.f};
#pragma unroll
      for (int ks = 0; ks < 2; ++ks) {
        h16x8 lf = *(const h16x8*)(lhs + fr * LWS + ks * 32 + fq * 8);
        h16x8 gf = *(const h16x8*)(rhs + fr * LWS + ks * 32 + fq * 8);
        m = __builtin_amdgcn_mfma_f32_16x16x32_f16(lf, gf, m, 0, 0, 0);
      }
#pragma unroll
      for (int r = 0; r < 4; ++r) { const int j = 4 * fq + r; const bool keep = (wq & 2) ? (j <= fr) : (j < fr); m[r] = keep ? m[r] : 0.f; }
      {
        if (wq == 0 || wq == 2) m = -m;
        h16x4 mh = {(h16)m[0], (h16)m[1], (h16)m[2], (h16)m[3]};
        *(h16x4*)((wq == 0 ? MBT : (wq == 1 ? MCA : (wq == 2 ? NBR : NCR))) + fr * TS + fq * 4) = mh;
      }
    }
    __syncthreads();
    {
      const bool lo2 = fq < 2;
      const h16x8 vf = lo2 ? *(const h16x8*)(VT + (wq * 16 + fr) * TS + fq * 8) : zero8;
      const h16x8 mcf = lo2 ? *(const h16x8*)(MCA + fr * TS + fq * 8) : zero8;
      f32x4 Xv = __builtin_amdgcn_mfma_f32_16x16x32_f16(mcf, vf, P1, 0, 0, 0);
      f32x4 ufin = {0.f, 0.f, 0.f, 0.f};
      {
        const h16x4 d1 = *(const h16x4*)(MBT + (4 * fq + 1) * TS + 4 * fq);
        const h16x4 d2 = *(const h16x4*)(MBT + (4 * fq + 2) * TS + 4 * fq);
        const h16x4 d3 = *(const h16x4*)(MBT + (4 * fq + 3) * TS + 4 * fq);
        const h16x4 ma = *(const h16x4*)(MBT + fr * TS + 4 * fq);
        const h16x8 maf = {ma[0], ma[1], ma[2], ma[3], 0, 0, 0, 0};
#pragma unroll
        for (int blk = 0; blk < 4; ++blk) {
          const float u0 = Xv[0];
          const float u1 = Xv[1] + (float)d1[0] * u0;
          const float u2 = Xv[2] + (float)d2[0] * u0 + (float)d2[1] * u1;
          const float u3 = Xv[3] + (float)d3[0] * u0 + (float)d3[1] * u1 + (float)d3[2] * u2;
          const bool mine = (fq == blk);
          ufin[0] = mine ? u0 : ufin[0]; ufin[1] = mine ? u1 : ufin[1]; ufin[2] = mine ? u2 : ufin[2]; ufin[3] = mine ? u3 : ufin[3];
          if (blk < 3) {
            const h16x8 ub = {(h16)u0, (h16)u1, (h16)u2, (h16)u3, 0, 0, 0, 0};
            Xv = __builtin_amdgcn_mfma_f32_16x16x32_f16(maf, mine ? ub : zero8, Xv, 0, 0, 0);
          }
        }
      }
      const h16x8 uf = {(h16)ufin[0], (h16)ufin[1], (h16)ufin[2], (h16)ufin[3], 0, 0, 0, 0};
      const h16x4 nb4 = *(const h16x4*)(NBR + fr * TS + 4 * fq);
      const h16x8 nbf = {nb4[0], nb4[1], nb4[2], nb4[3], 0, 0, 0, 0};
      const h16x8 ncf = lo2 ? *(const h16x8*)(NCR + fr * TS + fq * 8) : zero8;
      f32x4 Yv = __builtin_amdgcn_mfma_f32_16x16x32_f16(nbf, uf, P2, 0, 0, 0);
      Yv = __builtin_amdgcn_mfma_f32_16x16x32_f16(ncf, vf, Yv, 0, 0, 0);
      {
        h16* yb = Y + ((size_t)d * MALL + rbase + t0) * D + hh * 64 + wq * 16 + fr;
#pragma unroll
        for (int r = 0; r < 4; ++r) { const int s = 4 * fq + r; const int tok = d ? (TC - 1 - s) : s; yb[(size_t)tok * D] = (h16)(Yv[r] * YSC); }
      }
#pragma unroll
      for (int tt = 0; tt < 4; ++tt) {
        const h16x4 bt4 = *(const h16x4*)(BT + (tt * 16 + fr) * TS + fq * 4);
        const h16x8 btf = {bt4[0], bt4[1], bt4[2], bt4[3], 0, 0, 0, 0};
        const h16x8 ctf = lo2 ? *(const h16x8*)(CT + (tt * 16 + fr) * TS + fq * 8) : zero8;
        T[tt] = __builtin_amdgcn_mfma_f32_16x16x32_f16(btf, uf, T[tt], 0, 0, 0);
        T[tt] = __builtin_amdgcn_mfma_f32_16x16x32_f16(ctf, vf, T[tt], 0, 0, 0);
        f32x4 sc = *(const f32x4*)(WEC + tt * 16 + fq * 4);
        T[tt] = T[tt] * sc;
      }
    }
  }
#undef RAW_LOAD
#undef RAW_STORE
}

__device__ __forceinline__ void conv_unit(CP4& p, int l, int g, int rowbase, int stride, int L, int p0, char* smc) {
  const h16* Z = (const h16*)(p.ws + OFF_ZO + (size_t)(g & 1) * ZO_BYTES);
  h16* BP = (h16*)(p.ws + OFF_BPRE);
  h16* U = (h16*)smc;
  float* Yc = (float*)(smc + 62 * 512 * 2);
  int tid = ltid(), lane = tid & 63, wv = tid >> 6;
  __syncthreads();
#pragma unroll
  for (int i8 = 0; i8 < 8; ++i8) {
    const int pp = wv + 8 * i8;
    if (pp >= 62) break;
    int pos = p0 - 15 + pp;
    h16x8 o;
    if (pos >= 0 && pos < L) {
      size_t r = (size_t)(rowbase + pos * stride);
      h16x8 a = *(const h16x8*)(Z + r * ZOW + OC_CONV + lane * 8);
      h16x8 b = *(const h16x8*)(Z + r * ZOW + OC_CONV + 512 + lane * 8);
#pragma unroll
      for (int j = 0; j < 8; ++j) o[j] = (h16)((float)a[j] * sigmoidf_((float)b[j]));
    } else {
#pragma unroll
      for (int j = 0; j < 8; ++j) o[j] = (h16)0.f;
    }
    *(h16x8*)(U + pp * 512 + lane * 8) = o;
  }
  __syncthreads();
  {
    const float* dw = p.in[21] + (size_t)l * 31 * 512 + tid;
    float w[31];
#pragma unroll
    for (int j = 0; j < 31; ++j) w[j] = dw[j * 512];
    float bias = p.in[22][l * 512 + tid];
    float uin[62];
#pragma unroll
    for (int pp = 0; pp < 62; ++pp) uin[pp] = (float)U[pp * 512 + tid];
#pragma unroll
    for (int pp = 0; pp < 32; ++pp) {
      float acc = bias;
#pragma unroll
      for (int j = 0; j < 31; ++j) acc += uin[pp + j] * w[j];
      Yc[pp * 512 + tid] = acc;
    }
  }
  __syncthreads();
  const float* lg = p.in[23] + l * 512 + lane * 8;
  const float* lb = p.in[24] + l * 512 + lane * 8;
  float lgr[8], lbr[8];
#pragma unroll
  for (int j = 0; j < 8; ++j) { lgr[j] = lg[j]; lbr[j] = lb[j]; }
  for (int pp = wv; pp < 32; pp += 8) {
    float v[8]; float s = 0.f;
#pragma unroll
    for (int j = 0; j < 8; ++j) { v[j] = Yc[pp * 512 + lane * 8 + j]; s += v[j]; }
    float mean = wave_sum(s) * (1.0f / 512);
    float s2 = 0.f;
#pragma unroll
    for (int j = 0; j < 8; ++j) { v[j] -= mean; s2 += v[j] * v[j]; }
    float rstd = rsqrtf(wave_sum(s2) * (1.0f / 512) + 1e-5f);
    h16x8 o;
#pragma unroll
    for (int j = 0; j < 8; ++j) { float t = v[j] * rstd * lgr[j] + lbr[j]; o[j] = (h16)siluf_(t); }
    size_t r = (size_t)(rowbase + (p0 + pp) * stride);
    *(h16x8*)(BP + r * 512 + lane * 8) = o;
  }
}

__device__ __forceinline__ void sgu_unit(CP4& p, int l, int g, int row0, char* smc) {
  const h16* Z = (const h16*)(p.ws + OFF_ZO + (size_t)(g & 1) * ZO_BYTES);
  h16* CP = (h16*)(p.ws + OFF_CPRE);
  const h16* SW = (const h16*)(p.ws + OFF_SGUW);
  float* MEAN = (float*)smc;
  float* RSTD = MEAN + 128;
  h16* VT = (h16*)(smc + 1024);
  const int tid = ltid(), lane = tid & 63, wv = tid >> 6, fr = lane & 15, fq = lane >> 4;
  __syncthreads();
#pragma unroll 1
  for (int t4 = 0; t4 < 4; ++t4) {
    float s[4], s2[4];
#pragma unroll
    for (int k = 0; k < 4; ++k) {
      int tk = wv * 16 + t4 * 4 + k;
      h16x8 a = *(const h16x8*)(Z + (size_t)(row0 + tk) * ZOW + OC_SGU + 512 + lane * 8);
      s[k] = 0.f; s2[k] = 0.f;
#pragma unroll
      for (int j = 0; j < 8; ++j) { float v = geluf_((float)a[j]); s[k] += v; s2[k] += v * v; }
    }
#pragma unroll
    for (int m = 32; m >= 1; m >>= 1)
#pragma unroll
      for (int k = 0; k < 4; ++k) { s[k] += __shfl_xor(s[k], m, 64); s2[k] += __shfl_xor(s2[k], m, 64); }
    if (lane == 0) {
#pragma unroll
      for (int k = 0; k < 4; ++k) {
        float mean = s[k] * (1.0f / 512);
        float var = fmaxf(s2[k] * (1.0f / 512) - mean * mean, 0.f);
        MEAN[wv * 16 + t4 * 4 + k] = mean; RSTD[wv * 16 + t4 * 4 + k] = rsqrtf(var + 1e-5f);
      }
    }
  }
  __syncthreads();
  const float* lg = p.in[26] + l * 512;
  const float* lb = p.in[27] + l * 512;
  const float* bs = p.in[29] + (size_t)l * 8 * 128;
#pragma unroll 1
  for (int g8 = 0; g8 < 8; ++g8) {
    {
      const int qk = tid & 127, d0 = (tid >> 7) * 16;
      const float mean = MEAN[qk], rstd = RSTD[qk];
      const h16* src = Z + (size_t)(row0 + qk) * ZOW + OC_SGU + 512 + g8 * 64 + d0;
      h16x8 a0 = *(const h16x8*)src, a1 = *(const h16x8*)(src + 8);
#pragma unroll
      for (int j = 0; j < 8; ++j) {
        int c0 = g8 * 64 + d0 + j, c1 = c0 + 8;
        float v0 = (geluf_((float)a0[j]) - mean) * rstd * lg[c0] + lb[c0];
        float v1 = (geluf_((float)a1[j]) - mean) * rstd * lg[c1] + lb[c1];
        VT[(d0 + j) * 136 + qk] = (h16)v0;
        VT[(d0 + j + 8) * 136 + qk] = (h16)v1;
      }
    }
    __syncthreads();
    f32x4 acc[4];
#pragma unroll
    for (int dt = 0; dt < 4; ++dt) acc[dt] = (f32x4){0.f, 0.f, 0.f, 0.f};
#pragma unroll
    for (int ks = 0; ks < 4; ++ks) {
      h16x8 af = *(const h16x8*)(SW + ((size_t)g8 * 128 + wv * 16 + fr) * 128 + ks * 32 + fq * 8);
#pragma unroll
      for (int dt = 0; dt < 4; ++dt) {
        h16x8 bf = *(const h16x8*)(VT + (dt * 16 + fr) * 136 + ks * 32 + fq * 8);
        acc[dt] = __builtin_amdgcn_mfma_f32_16x16x32_f16(bf, af, acc[dt], 0, 0, 0);
      }
    }
    {
      const int pr = wv * 16 + fr;
      const float bias = bs[g8 * 128 + pr];
      const h16* up = Z + (size_t)(row0 + pr) * ZOW + OC_SGU + g8 * 64 + fq * 4;
      h16* cp = CP + (size_t)(row0 + pr) * 512 + g8 * 64 + fq * 4;
      h16x4 u4[4];
#pragma unroll
      for (int dt = 0; dt < 4; ++dt) u4[dt] = *(const h16x4*)(up + dt * 16);
#pragma unroll
      for (int dt = 0; dt < 4; ++dt) {
        h16x4 o;
#pragma unroll
        for (int j = 0; j < 4; ++j) o[j] = (h16)(geluf_((float)u4[dt][j]) * (acc[dt][j] + bias));
        *(h16x4*)(cp + dt * 16) = o;
      }
    }
    __syncthreads();
  }
}

__device__ __forceinline__ void phase_scan(CP4& p, int l, char* smc) {
  for (int pr = blockIdx.x; pr < NB * 16; pr += gridDim.x) scan_pair(p, l, pr >> 4, pr & 15, smc);
}
__device__ __forceinline__ void phase_convsgu(CP4& p, int l, int g, char* smc) {
  const bool last = (l == DEPTH - 1);
  int nb = gridDim.x, bi = blockIdx.x;
  int nconv_lat = GB * 64, nconv = nconv_lat + (last ? 0 : GB * 8);
  for (int u = (bi + nb - 144 % nb) % nb; u < nconv; u += nb) {
    int rowbase, stride, Lc, p0;
    if (u < nconv_lat) {
      int bl = u >> 6, w = u & 63;
      if ((l & 1) == 0) { rowbase = bl * SEQ + (w >> 1) * 64; stride = 1; Lc = 64; p0 = (w & 1) * 32; }
      else { rowbase = bl * SEQ + w; stride = 64; Lc = 32; p0 = 0; }
    } else {
      int uu = u - nconv_lat, bl = uu >> 3, sg = uu & 7;
      rowbase = MLAT + bl * CTX; stride = 1; Lc = CTX; p0 = sg * 32;
    }
    conv_unit(p, l, g, rowbase, stride, Lc, p0, smc);
  }
  int nsgu = last ? MLAT / 128 : MG / 128;
  for (int u = nb - 1 - bi; u < nsgu; u += nb) sgu_unit(p, l, g, u * 128, smc);
}

__device__ __forceinline__ void phase_postscan(CP4& p, int l, char* smc) {
  const bool last = (l == DEPTH - 1);
  const h16* Z = (const h16*)(p.ws + OFF_ZR);
  const h16* Y = (const h16*)(p.ws + OFF_YH);
  const h16* GT = (const h16*)(p.ws + OFF_GUPT);
  h16* AP = (h16*)(p.ws + OFF_APRE);
  const float* sw = p.in[9] + (size_t)l * 3 * RC;
  float* SWR = (float*)smc;
  float* GNC = SWR + 9 * 1024;
  h16* SG = (h16*)(GNC + 3 * 1024);
  h16* G = SG + 32 * 136;
  const int tid = ltid(), lane = tid & 63, wv = tid >> 6, fr = lane & 15, fq = lane >> 4;
  __syncthreads();
  for (int e = tid; e < 9 * 1024; e += NTHREADS) { int st = e >> 10, col = e & 1023, sg = st / 3, tap = st % 3; SWR[e] = sw[tap * RC + sg * D + col]; }
  for (int e = tid; e < 1024; e += NTHREADS) { GNC[e] = p.in[18][l * D + e]; GNC[1024 + e] = p.in[19][l * D + e]; GNC[2048 + e] = p.in[17][l * D + e]; }
  float sg0[8], sg1[8], sg2[8];
  {
    int kc = (tid & 15) * 8;
#pragma unroll
    for (int j = 0; j < 8; ++j) { sg0[j] = sw[3328 + kc + j]; sg1[j] = sw[RC + 3328 + kc + j]; sg2[j] = sw[2 * RC + 3328 + kc + j]; }
  }
  const h16x8 zero8 = {0, 0, 0, 0, 0, 0, 0, 0};
  const int ntiles = MALL / 32;
  for (int u = blockIdx.x; u < ntiles; u += gridDim.x) {
    const int row0 = u * 32;
    if (last && (row0 % MG) >= MLAT) continue;
    __syncthreads();
    {
      int tok = tid >> 4, kc = (tid & 15) * 8;
      int r = row0 + tok, t, L; seqposG(r, t, L);
      const h16* zp = Z + (size_t)r * ZRW + 3328 + kc;
      h16x8 b = *(const h16x8*)zp;
      h16x8 a = (t > 0) ? *(const h16x8*)(zp - ZRW) : zero8;
      h16x8 c = (t < L - 1) ? *(const h16x8*)(zp + ZRW) : zero8;
      h16x8 o;
#pragma unroll
      for (int j = 0; j < 8; ++j) o[j] = (h16)sigmoidf_((float)a[j] * sg0[j] + (float)b[j] * sg1[j] + (float)c[j] * sg2[j]);
      *(h16x8*)(SG + tok * 136 + kc) = o;
    }
    __syncthreads();
    {
      h16x8 af[2][4];
#pragma unroll
      for (int m = 0; m < 2; ++m)
#pragma unroll
        for (int ks = 0; ks < 4; ++ks) af[m][ks] = *(const h16x8*)(SG + (m * 16 + fr) * 136 + ks * 32 + fq * 8);
#pragma unroll
      for (int nt = 0; nt < 8; ++nt) {
        f32x4 acc0 = {0.f, 0.f, 0.f, 0.f}, acc1 = {0.f, 0.f, 0.f, 0.f};
        const h16* bp = GT + (size_t)(wv * 128 + nt * 16 + fr) * 128 + fq * 8;
#pragma unroll
        for (int ks = 0; ks < 4; ++ks) {
          h16x8 bf = *(const h16x8*)(bp + ks * 32);
          acc0 = __builtin_amdgcn_mfma_f32_16x16x32_f16(af[0][ks], bf, acc0, 0, 0, 0);
          acc1 = __builtin_amdgcn_mfma_f32_16x16x32_f16(af[1][ks], bf, acc1, 0, 0, 0);
        }
#pragma unroll
        for (int rg = 0; rg < 4; ++rg) {
          G[(fq * 4 + rg) * 1024 + wv * 128 + nt * 16 + fr] = (h16)acc0[rg];
          G[(16 + fq * 4 + rg) * 1024 + wv * 128 + nt * 16 + fr] = (h16)acc1[rg];
        }
      }
    }
    __syncthreads();
#pragma unroll 1
    for (int it = 0; it < 8; ++it) {
      const int tok = (tid >> 7) + 4 * it, col = (tid & 127) * 8;
      const int r = row0 + tok; int t, L; seqposG(r, t, L);
      const bool hp = t > 0, hn = t < L - 1;
      const h16* zp = Z + (size_t)r * ZRW + col;
      h16x8 yf = *(const h16x8*)(Y + (size_t)r * D + col), yb = *(const h16x8*)(Y + ((size_t)MALL + r) * D + col);
      h16x8 z[3][3];
#pragma unroll
      for (int sg = 0; sg < 3; ++sg) {
        z[sg][1] = *(const h16x8*)(zp + sg * D);
        z[sg][0] = hp ? *(const h16x8*)(zp + sg * D - ZRW) : zero8;
        z[sg][2] = hn ? *(const h16x8*)(zp + sg * D + ZRW) : zero8;
      }
      float y[8], s = 0.f;
#pragma unroll
      for (int j = 0; j < 8; ++j) { y[j] = ((float)yf[j] + (float)yb[j]) * YUN; s += y[j]; }
      s += __shfl_xor(s, 1, 64); s += __shfl_xor(s, 2, 64); s += __shfl_xor(s, 4, 64);
      const float mean = s * (1.0f / 64);
      float s2 = 0.f;
#pragma unroll
      for (int j = 0; j < 8; ++j) { y[j] -= mean; s2 += y[j] * y[j]; }
      s2 += __shfl_xor(s2, 1, 64); s2 += __shfl_xor(s2, 2, 64); s2 += __shfl_xor(s2, 4, 64);
      const float rstd = rsqrtf(s2 * (1.0f / 64) + 64e-5f);
      float vv[8], bs = 0.f;
#pragma unroll
      for (int j = 0; j < 8; ++j) {
        float rr = (float)z[0][0][j] * SWR[0 * 1024 + col + j] + (float)z[0][1][j] * SWR[1 * 1024 + col + j] + (float)z[0][2][j] * SWR[2 * 1024 + col + j];
        float kk = (float)z[1][0][j] * SWR[3 * 1024 + col + j] + (float)z[1][1][j] * SWR[4 * 1024 + col + j] + (float)z[1][2][j] * SWR[5 * 1024 + col + j];
        vv[j] = (float)z[2][0][j] * SWR[6 * 1024 + col + j] + (float)z[2][1][j] * SWR[7 * 1024 + col + j] + (float)z[2][2][j] * SWR[8 * 1024 + col + j];
        bs += rr * kk * GNC[2048 + col + j];
      }
      bs += __shfl_xor(bs, 1, 64); bs += __shfl_xor(bs, 2, 64); bs += __shfl_xor(bs, 4, 64);
      const h16x8 g8 = *(const h16x8*)(G + tok * 1024 + col);
      h16x8 o;
#pragma unroll
      for (int j = 0; j < 8; ++j) {
        float yn = y[j] * rstd * GNC[col + j] + GNC[1024 + col + j];
        o[j] = (h16)((yn + bs * vv[j]) * (float)g8[j]);
      }
      *(h16x8*)(AP + (size_t)r * D + col) = o;
    }
  }
}

constexpr int NLS = 5, NST = 6, NLE = 3;
constexpr int NPL = NLS + NG * NST + NLE;
constexpr int NPHASE = 2 + DEPTH * NPL + 1;

__device__ __forceinline__ void decode_phase(int ph, int& kind, int& l, int& g, int& st) {
  l = g = st = 0;
  if (ph == 0) { kind = 0; return; }
  if (ph == 1) { kind = 1; return; }
  if (ph == NPHASE - 1) { kind = 2; return; }
  int q = ph - 2; l = q / NPL; int s = q % NPL;
  if (s < NLS) { kind = 3; st = s; return; }
  s -= NLS;
  if (s < NG * NST) { kind = 4; g = s / NST; st = s % NST; return; }
  kind = 3; st = NLS + (s - NG * NST);
}
__device__ __forceinline__ bool step_needs_sync(int kind, int l, int g, int st) {
  if (kind == 3 && st == 0 && l > 0) return false;
  if (kind != 4) return true;
  if (st == 0) return g == 0;
  return st == 2 || st == 4 || st == 5;
}

__device__ __forceinline__ void run_nongemm(CP4& p, int kind, int l, int g, int st, char* smc) {
  if (kind == 0) phase_mod(p, (float*)smc);
  else if (kind == 1) phase_copyx(p);
  else if (kind == 2) phase_final(p);
  else if (kind == 3) {
    if (st == 1) phase_norm(p, l, 0);
    else if (st == 3) phase_scan(p, l, smc);
    else if (st == 4) phase_postscan(p, l, smc);
    else if (st == 5) phase_norm(p, l, 1);
  } else {
    if (st == 1) phase_convsgu(p, l, g, smc);
  }
}

__device__ __forceinline__ int opq(int x) { asm volatile("" : "+v"(x)); return __builtin_amdgcn_readfirstlane(x); }
__device__ __forceinline__ size_t opq64(size_t x) { int lo = opq((int)(unsigned)x), hi = opq((int)(unsigned)(x >> 32)); return ((size_t)(unsigned)hi << 32) | (unsigned)lo; }
struct GemmDesc { size_t offA, offB, offO, offZ; int K, nM, nN, mode, goff, ldo, ubeg, uend, brot, nblk, valid; };
__device__ __forceinline__ GemmDesc gemm_desc(int kind, int l, int g, int st, int j) {
  const bool last = (l == DEPTH - 1);
  const int nMr = (last ? MLAT : MG) / BM;
  const int grid = gridDim.x;
  GemmDesc d{};
  d.brot = 0; d.nblk = grid; d.valid = 0; d.offZ = OFF_ZO + (size_t)(g & 1) * ZO_BYTES;
  if (kind == 3) {
    if (j != 0) return d;
    d.valid = 1;
    if (st == 2) { d.offA = OFF_HALL; d.offB = OFF_WINT; d.offO = OFF_ZR; d.K = D; d.nM = MALL / BM; d.nN = ZRW / BM; d.mode = 0; d.ldo = ZRW; }
    else if (st == 6) { d.offA = OFF_HALL; d.offB = OFF_FFNINT; d.offO = OFF_HID; d.K = D; d.nM = MALL / BM; d.nN = 2 * DFF / BM; d.mode = 5; d.ldo = DFF; }
    else if (st == 7) { d.offA = OFF_HID; d.offB = (l & 1) ? OFF_FFNOUTT2 : OFF_FFNOUTT; d.offO = OFF_HID; d.K = DFF; d.nM = MALL / BM; d.nN = D / BM; d.mode = 4; d.goff = 5120; d.ldo = D; }
    else d.valid = 0;
    d.ubeg = 0; d.uend = d.nM * d.nN;
    return d;
  }
  if (kind != 4) return d;
  const bool shadow = (j > 0);
  const int gz = shadow ? g + 1 : g;
  if ((st == 0 && j == 0 && g == 0) || (shadow && gz < NG && ((st == 4 && j == 1) || (st == 5)))) {
    d.valid = 1;
    d.offA = OFF_HALL + (size_t)gz * MG * D * 2; d.offB = OFF_WINT + (size_t)ZRW * D * 2; d.offO = OFF_ZO + (size_t)(gz & 1) * ZO_BYTES;
    d.K = D; d.nM = nMr; d.nN = ZOW / BM; d.mode = 0; d.ldo = ZOW;
    const int tot = d.nM * d.nN;
    d.ubeg = 0; d.uend = tot;
    if (shadow) {
      const int nsh = grid > 144 ? grid - 144 : 0;
      const int nA = min(3 * nsh, tot), nB1 = min(nA + 2 * nsh, tot);
      if (st == 4) { d.ubeg = 0; d.uend = nA; d.brot = 144; d.nblk = nsh; }
      else if (j == 1) { d.ubeg = nA; d.uend = nB1; d.brot = 144; d.nblk = nsh; }
      else { d.ubeg = nB1; d.uend = tot; d.brot = 0; d.nblk = grid; }
      if (d.ubeg >= d.uend) d.valid = 0;
    }
    return d;
  }
  if (j != 0) return d;
  d.valid = 1; d.nM = nMr; d.nN = D / BM; d.ldo = D; d.offO = OFF_M16;
  if (st == 2) { d.offA = OFF_APRE + (size_t)g * MG * D * 2; d.offB = OFF_ROUTT; d.K = 1024; d.mode = 1; }
  else if (st == 3) { d.offA = OFF_BPRE; d.offB = OFF_COUTT; d.K = 512; d.mode = 2; }
  else if (st == 4) { d.offA = OFF_CPRE; d.offB = OFF_SOUTT; d.K = 512; d.mode = 3; }
  else if (st == 5) { d.offA = OFF_M16; d.offB = OFF_WMT; d.K = D; d.mode = 4; d.goff = 2048; }
  else d.valid = 0;
  d.ubeg = 0; d.uend = d.nM * d.nN;
  return d;
}

__global__ void __launch_bounds__(NTHREADS) mk(P p, int ph0, int ph1, int coop) {
  extern __shared__ __attribute__((aligned(16))) char smc[];
  cg::grid_group grid = cg::this_grid();
  CP4* pp = (CP4*)__builtin_amdgcn_kernarg_segment_ptr();
  unsigned nbar = 0;
#pragma nounroll
  for (int ph = ph0; ph < ph1; ++ph) {
    CP4* q = pp;
    asm volatile("" : "+s"(q));
    int kind, l, g, st; decode_phase(ph, kind, l, g, st);
    run_nongemm(*q, kind, l, g, st, smc);
#pragma nounroll
    for (int j = 0; j < 3; ++j) {
      GemmDesc d = gemm_desc(kind, l, g, st, j);
      d.offA = opq64(d.offA); d.offB = opq64(d.offB); d.offO = opq64(d.offO); d.offZ = opq64(d.offZ);
      d.K = opq(d.K); d.nM = opq(d.nM); d.nN = opq(d.nN); d.mode = opq(d.mode); d.goff = opq(d.goff); d.ldo = opq(d.ldo);
      d.ubeg = opq(d.ubeg); d.uend = opq(d.uend); d.brot = opq(d.brot); d.nblk = opq(d.nblk); d.valid = opq(d.valid);
      if (!d.valid) continue;
      char* ws = q->ws;
      EpiAny e{d.mode, (h16*)(ws + d.offO), (const h16*)(ws + d.offZ), nullptr, q->out, ws, l, (kind == 3 ? 0 : g), d.goff, d.ldo};
      gemm_phase((LAS unsigned char*)smc, (const h16*)(ws + d.offA), (const h16*)(ws + d.offB), d.K, 0, d.nM, d.nN, d.ubeg, d.uend, d.brot, d.nblk, e);
    }
    {
      int cl = -1, cb0 = 0;
      if (kind == 3 && st == 0 && l == 0) cl = 0;
      if (kind == 3 && st == 7 && l + 1 < DEPTH) { cl = l + 1; cb0 = (gridDim.x > 128) ? 64 : 0; }
      if (cl >= 0) phase_convert(*q, cl, (float*)smc, cb0, (int)gridDim.x - cb0);
    }
    if (coop && ph + 1 < ph1 && step_needs_sync(kind, l, g, st) && ph >= 2) {
      if (ph == 2) grid.sync();
      else { ++nbar; grid_bar((unsigned*)(q->ws + OFF_BAR), nbar * gridDim.x); }
    }
  }
}

extern "C" void kernel_launch(void* const* d_in, const int* in_sizes, int n_in, void* d_out, int out_size, void* d_ws, size_t ws_size,
                              hipStream_t stream) {
  if (ws_size < WS_TOTAL) return;
  P p{};
  for (int i = 0; i < 35; ++i) p.in[i] = (const float*)d_in[i];
  p.out = (float*)d_out;
  p.ws = (char*)d_ws;
  static bool attr = false;
  if (!attr) { (void)hipFuncSetAttribute((const void*)mk, hipFuncAttributeMaxDynamicSharedMemorySize, SHM_BYTES); attr = true; }
#if COOP
  static int grid_blocks = 0;
  if (!grid_blocks) {
    int dev = 0, cus = 0, per_cu = 0;
    (void)hipGetDevice(&dev);
    (void)hipDeviceGetAttribute(&cus, hipDeviceAttributeMultiprocessorCount, dev);
    (void)hipOccupancyMaxActiveBlocksPerMultiprocessor(&per_cu, mk, NTHREADS, SHM_BYTES);
    grid_blocks = cus;
  }
  (void)hipMemsetAsync((char*)d_ws + OFF_BAR, 0, 256, stream);
  int ph0 = 0, ph1 = NPHASE, coop = 1;
  void* args[] = {&p, &ph0, &ph1, &coop};
  (void)hipLaunchCooperativeKernel((void*)mk, dim3(grid_blocks), dim3(NTHREADS), args, SHM_BYTES, stream);
#else
  for (int ph = 0; ph < NPHASE; ++ph) mk<<<256, NTHREADS, SHM_BYTES, stream>>>(p, ph, ph + 1, 0);
#endif
}
```
